# Optimizing an MI355X kernel written in HIP

```python
import math
import jax, jax.numpy as jnp
from jax import lax
import numpy as np


D_MODEL = 1024
BATCH = 2
SEQ = 16384
DEPTH = 2

MEM_LEN = 256
SB_HEADS = 4
SB_HEAD_DIM = 128
SB_WIDTH = SB_HEADS * SB_HEAD_DIM
Q_BLOCK = 128
POOL_WINDOWS = (2, 4, 8, 16)
POOL_GROUPS = 4
POOL_GROUP_DIM = 128
POOL_WIDTH = POOL_GROUPS * POOL_GROUP_DIM
LRU_BLOCKS = 8
LRU_BLOCK_DIM = 64
LRU_WIDTH = LRU_BLOCKS * LRU_BLOCK_DIM
CONV_WIDTH = 4
LRU_C = 8.0
XA_HEADS = 4
XA_HEAD_DIM = 128
XA_WIDTH = XA_HEADS * XA_HEAD_DIM
N_BRANCH = 4
BRANCH_WIDTH = 512
DN_ALPHA = (2 * DEPTH) ** 0.25
DN_BETA = (8 * DEPTH) ** -0.25
LN_EPS = 1e-5
SPLIT_SIZES = (SB_WIDTH, SB_WIDTH, SB_WIDTH, SB_WIDTH, POOL_WIDTH, POOL_WIDTH, LRU_WIDTH, LRU_WIDTH, XA_WIDTH, XA_WIDTH, N_BRANCH * D_MODEL)
IN_WIDTH = 10 * 512 + N_BRANCH * D_MODEL

kernel_name = 'hybrid_stickbreak_pool_rglru_memxattn'


def _split_columns(p):
    out, off = [], 0
    for size in SPLIT_SIZES:
        out.append(p[..., off:off + size])
        off += size
    return out


def layer_norm(x, g, b):
    xf = x.astype(jnp.float32)
    mean = jnp.mean(xf, axis=-1, keepdims=True)
    var = jnp.mean(jnp.square(xf - mean), axis=-1, keepdims=True)
    y = (xf - mean) * lax.rsqrt(var + LN_EPS) * g.astype(jnp.float32) + b.astype(jnp.float32)
    return y.astype(x.dtype)


def stick_breaking_attention(q, k, v):
    b, s, h, d = q.shape
    nb = s // Q_BLOCK
    scale = 1.0 / math.sqrt(d)
    qh = q.transpose(0, 2, 1, 3)
    kh = k.transpose(0, 2, 1, 3).reshape(b, h, nb, Q_BLOCK, d)
    vh = v.transpose(0, 2, 1, 3).reshape(b, h, nb, Q_BLOCK, d)
    loc = jnp.arange(Q_BLOCK)
    suffix = (loc[:, None] > loc[None, :]).astype(jnp.float32)
    diag_valid = loc[None, :] < loc[:, None]
    outs = []
    for i in range(nb):
        nk = i + 1
        q_blk = qh[:, :, i * Q_BLOCK:(i + 1) * Q_BLOCK]
        k_pre = kh[:, :, :nk]
        v_pre = vh[:, :, :nk]
        z = jnp.einsum('bhqd,bhnkd->bhqnk', q_blk, k_pre, preferred_element_type=jnp.float32) * scale
        blk_idx = jnp.arange(nk)
        valid = (blk_idx[None, :, None] < i) | diag_valid[:, None, :]
        log_1m = jnp.where(valid, jax.nn.log_sigmoid(-z), 0.0)
        within = jnp.einsum('bhqnk,kj->bhqnj', log_1m, suffix)
        totals = jnp.sum(log_1m, axis=-1)
        later = lax.cumsum(totals, axis=3, reverse=True) - totals
        w = jnp.where(valid, jnp.exp(jax.nn.log_sigmoid(z) + within + later[..., None]), 0.0)
        o = jnp.einsum('bhqnk,bhnkd->bhqd', w.astype(v.dtype), v_pre, preferred_element_type=jnp.float32)
        outs.append(o.astype(v.dtype))
    out = jnp.concatenate(outs, axis=2)
    return out.transpose(0, 2, 1, 3).reshape(b, s, h * d)


def multiscale_pool(u, w_pool, pool_scale):
    b, s, c = u.shape
    uf = u.astype(jnp.float32)
    csum = jnp.concatenate([jnp.zeros((b, 1, c), jnp.float32), jnp.cumsum(uf, axis=1)], axis=1)
    pos = jnp.arange(s)
    groups = []
    for g, win in enumerate(POOL_WINDOWS):
        sl = slice(g * POOL_GROUP_DIM, (g + 1) * POOL_GROUP_DIM)
        start = jnp.maximum(pos + 1 - win, 0)
        window_sum = csum[:, 1:, sl] - csum[:, start, sl]
        count = (pos + 1 - start).astype(jnp.float32)[None, :, None]
        groups.append(window_sum / count - uf[:, :, sl])
    pooled = jnp.stack(groups, axis=2)
    mixed = jnp.einsum('bsgi,gij->bsgj', pooled, w_pool.astype(jnp.float32)).reshape(b, s, c)
    return (mixed * pool_scale.astype(jnp.float32)).astype(u.dtype)


def rg_lru(u, conv_w, conv_b, w_rg, b_rg, w_ig, b_ig, lru_L):
    b, s, c = u.shape
    xc = lax.conv_general_dilated(u, conv_w[:, None, :], window_strides=(1,), padding=[(CONV_WIDTH - 1, 0)],
                                  dimension_numbers=('NWC', 'WIO', 'NWC'), feature_group_count=c) + conv_b
    xb = xc.reshape(b, s, LRU_BLOCKS, LRU_BLOCK_DIM)
    r = jax.nn.sigmoid(jnp.einsum('bshi,hij->bshj', xb, w_rg).reshape(b, s, c) + b_rg)
    i = jax.nn.sigmoid(jnp.einsum('bshi,hij->bshj', xb, w_ig).reshape(b, s, c) + b_ig)
    log_a = (-LRU_C * r.astype(jnp.float32)) * jax.nn.softplus(-lru_L.astype(jnp.float32))
    a = jnp.exp(log_a)
    mult = jnp.sqrt(-jnp.expm1(2.0 * log_a))
    bx = mult * (i * xc).astype(jnp.float32)

    def combine(left, right):
        a_l, b_l = left
        a_r, b_r = right
        return a_l * a_r, a_r * b_l + b_r

    _, h = lax.associative_scan(combine, (a, bx), axis=1)
    return h.astype(u.dtype)


def memory_cross_attention(q, mem, w_mem_kv):
    b, s, _ = q.shape
    m = mem.shape[1]
    kv = mem @ w_mem_kv
    k = kv[..., :XA_WIDTH].reshape(b, m, XA_HEADS, XA_HEAD_DIM)
    v = kv[..., XA_WIDTH:].reshape(b, m, XA_HEADS, XA_HEAD_DIM)
    qh = q.reshape(b, s, XA_HEADS, XA_HEAD_DIM)
    scores = jnp.einsum('bshd,bmhd->bhsm', qh, k, preferred_element_type=jnp.float32) / math.sqrt(XA_HEAD_DIM)
    p = jax.nn.softmax(scores, axis=-1)
    out = jnp.einsum('bhsm,bmhd->bshd', p.astype(v.dtype), v)
    return out.reshape(b, s, XA_WIDTH)


def hybrid_layer(x, mem, w_in, w_pool, pool_scale, conv_w, conv_b, w_rg, b_rg, w_ig, b_ig, lru_L,
                 w_mem_kv, w_branch, w_out, ln_g, ln_b):
    b, s, d = x.shape
    proj = x @ w_in
    (q_sb, k_sb, v_sb, g_sb, u_pool, g_pool, u_lru, g_lru, q_xa, g_xa, merge) = _split_columns(proj)
    hs = (b, s, SB_HEADS, SB_HEAD_DIM)
    y_sb = stick_breaking_attention(q_sb.reshape(hs), k_sb.reshape(hs), v_sb.reshape(hs)) * jax.nn.silu(g_sb)
    y_pool = multiscale_pool(u_pool, w_pool, pool_scale) * jax.nn.silu(g_pool)
    y_lru = rg_lru(u_lru, conv_w, conv_b, w_rg, b_rg, w_ig, b_ig, lru_L) * jax.nn.silu(g_lru)
    y_xa = memory_cross_attention(q_xa, mem, w_mem_kv) * jax.nn.silu(g_xa)
    gates = jax.nn.sigmoid(merge.reshape(b, s, N_BRANCH, d))
    branches = (y_sb, y_pool, y_lru, y_xa)
    merged = gates[:, :, 0] * (branches[0] @ w_branch[0])
    for n in range(1, N_BRANCH):
        merged = merged + gates[:, :, n] * (branches[n] @ w_branch[n])
    out = merged @ w_out
    return layer_norm(DN_ALPHA * x + out, ln_g, ln_b)


def setup_inputs(seed: int = 0) -> dict:
    key = jax.random.key(seed)
    ks = jax.random.split(key, 20)
    f32 = jnp.float32
    nrm = lambda k, shape, fan_in, mult=1.0: jax.random.normal(k, shape, f32) * (fan_in ** -0.5) * mult
    x = jax.random.normal(ks[0], (BATCH, SEQ, D_MODEL), f32)
    mem = jax.random.normal(ks[1], (BATCH, MEM_LEN, D_MODEL), f32)
    w_in = nrm(ks[2], (DEPTH, D_MODEL, IN_WIDTH), D_MODEL)
    w_pool = nrm(ks[3], (DEPTH, POOL_GROUPS, POOL_GROUP_DIM, POOL_GROUP_DIM), POOL_GROUP_DIM)
    pool_scale = 1.0 + 0.02 * jax.random.normal(ks[4], (DEPTH, POOL_WIDTH), f32)
    conv_w = nrm(ks[5], (DEPTH, CONV_WIDTH, LRU_WIDTH), CONV_WIDTH)
    conv_b = 0.01 * jax.random.normal(ks[6], (DEPTH, LRU_WIDTH), f32)
    w_rg = nrm(ks[7], (DEPTH, LRU_BLOCKS, LRU_BLOCK_DIM, LRU_BLOCK_DIM), LRU_BLOCK_DIM)
    b_rg = 0.01 * jax.random.normal(ks[8], (DEPTH, LRU_WIDTH), f32)
    w_ig = nrm(ks[9], (DEPTH, LRU_BLOCKS, LRU_BLOCK_DIM, LRU_BLOCK_DIM), LRU_BLOCK_DIM)
    b_ig = 0.01 * jax.random.normal(ks[10], (DEPTH, LRU_WIDTH), f32)
    a_c = jax.random.uniform(ks[11], (DEPTH, LRU_WIDTH), f32, minval=0.9, maxval=0.999)
    sig = a_c ** (1.0 / LRU_C)
    lru_L = jnp.log(sig) - jnp.log1p(-sig)
    w_mem_kv = nrm(ks[12], (DEPTH, D_MODEL, 2 * XA_WIDTH), D_MODEL)
    w_branch = nrm(ks[13], (DEPTH, N_BRANCH, BRANCH_WIDTH, D_MODEL), BRANCH_WIDTH, DN_BETA)
    w_out = nrm(ks[14], (DEPTH, D_MODEL, D_MODEL), D_MODEL, DN_BETA)
    ln_g = 1.0 + 0.02 * jax.random.normal(ks[15], (DEPTH, D_MODEL), f32)
    ln_b = 0.02 * jax.random.normal(ks[16], (DEPTH, D_MODEL), f32)
    return {'x': x, 'mem': mem, 'w_in': w_in, 'w_pool': w_pool, 'pool_scale': pool_scale,
            'conv_w': conv_w, 'conv_b': conv_b, 'w_rg': w_rg, 'b_rg': b_rg, 'w_ig': w_ig, 'b_ig': b_ig,
            'lru_L': lru_L, 'w_mem_kv': w_mem_kv, 'w_branch': w_branch, 'w_out': w_out,
            'ln_g': ln_g, 'ln_b': ln_b}


def reference(x, mem, w_in, w_pool, pool_scale, conv_w, conv_b, w_rg, b_rg, w_ig, b_ig, lru_L,
              w_mem_kv, w_branch, w_out, ln_g, ln_b):
    for l in range(DEPTH):
        x = hybrid_layer(x, mem, w_in[l], w_pool[l], pool_scale[l], conv_w[l], conv_b[l], w_rg[l], b_rg[l],
                         w_ig[l], b_ig[l], lru_L[l], w_mem_kv[l], w_branch[l], w_out[l], ln_g[l], ln_b[l])
    return x
```

```cpp
#include <hip/hip_runtime.h>
#include <hip/hip_cooperative_groups.h>
#include <cstdio>
#include <cstdint>
namespace cg = cooperative_groups;

#define LAS __attribute__((address_space(3)))
typedef unsigned short bf16_t;
typedef short bf16x8 __attribute__((ext_vector_type(8)));
typedef float f32x4 __attribute__((ext_vector_type(4)));
typedef unsigned u32x4 __attribute__((ext_vector_type(4)));
typedef unsigned u32x2 __attribute__((ext_vector_type(2)));

constexpr int DM = 1024, SEQ = 16384, NBATCH = 2, NIN = 9216, PW = 5120, MEMLEN = 256, NLAYER = 2;
constexpr float DN_ALPHA = 1.41421356237f, LN_EPS = 1e-5f;
constexpr size_t MiB = 1024 * 1024;
constexpr size_t WS_SMALL = 1 * MiB;
constexpr size_t WS_MEMB = 2 * MiB;
constexpr size_t WS_KVM = 3 * MiB;
constexpr size_t WS_AGG = 5 * MiB;
constexpr size_t WS_WIN = 8 * MiB;
constexpr size_t WS_WB = 44 * MiB;
constexpr size_t WS_WO = 60 * MiB;
constexpr size_t WS_WKV = 64 * MiB;
constexpr size_t WS_XN = 72 * MiB;
constexpr size_t WS_PROJ = 136 * MiB;
constexpr size_t WS_Y = 296 * MiB;
constexpr size_t WS_GSCR = 360 * MiB;
constexpr size_t WS_END = 488 * MiB;
constexpr int LDS_BYTES = 147456;
constexpr int LDS_BARW = 147456 - 64;

__device__ __forceinline__ unsigned cvt_pk_bf16(float lo, float hi) { unsigned r; asm volatile("v_cvt_pk_bf16_f32 %0, %1, %2" : "=v"(r) : "v"(lo), "v"(hi)); return r; }
__device__ __forceinline__ float bf_lo(unsigned u) { return __uint_as_float(u << 16); }
__device__ __forceinline__ float bf_hi(unsigned u) { return __uint_as_float(u & 0xffff0000u); }
__device__ __forceinline__ float bf1(bf16_t u) { return __uint_as_float(((unsigned)u) << 16); }
__device__ __forceinline__ float rcp_(float x) { return __builtin_amdgcn_rcpf(x); }
__device__ __forceinline__ float sigmoidf_(float x) { return rcp_(1.0f + __expf(-x)); }
__device__ __forceinline__ float siluf_(float x) { return x * rcp_(1.0f + __expf(-x)); }
__device__ __forceinline__ int tid_() { int t = threadIdx.x; asm volatile("" : "+v"(t)); return t; }
__device__ __forceinline__ int bid_() { int t = blockIdx.x; asm volatile("" : "+s"(t)); return t; }
__device__ __forceinline__ float bperm(int addr4, float v) { return __int_as_float(__builtin_amdgcn_ds_bpermute(addr4, __float_as_int(v))); }
typedef short s16x4 __attribute__((ext_vector_type(4)));
__device__ __forceinline__ u32x2 lds_tr16(const LAS bf16_t* p) { return __builtin_bit_cast(u32x2, __builtin_amdgcn_ds_read_tr16_b64_v4i16((LAS s16x4*)p)); }
__device__ __forceinline__ __amdgpu_buffer_rsrc_t mk_rsrc(const void* p) { return __builtin_amdgcn_make_buffer_rsrc((void*)p, 0, 0x7fffffff, 0x00020000); }
__device__ __forceinline__ void st_wt16(__amdgpu_buffer_rsrc_t rs, int byte_off, u32x4 v) { __builtin_amdgcn_raw_buffer_store_b128(v, rs, byte_off, 0, 16); }
__device__ __forceinline__ void st_wt8(__amdgpu_buffer_rsrc_t rs, int byte_off, u32x2 v) { __builtin_amdgcn_raw_buffer_store_b64(v, rs, byte_off, 0, 16); }
__device__ __forceinline__ int tile_of(int u) { return ((((u & 7) >> 2) * 2 + (u >> 8)) * 32) + ((u & 255) >> 3); }
__device__ __forceinline__ void store_row_tiles(const __amdgpu_buffer_rsrc_t rs, const int base_byte, const u32x2 (&r)[8], const int lane, const int quad) {
    const bool odd = (quad & 1) != 0; const int pa = (lane ^ 16) << 2;
#pragma unroll
    for (int tp = 0; tp < 4; ++tp) {
        const u32x2 mine0 = r[2 * tp], mine1 = r[2 * tp + 1];
        const u32x2 snd = odd ? mine0 : mine1; u32x2 rcv;
        rcv.x = (unsigned)__builtin_amdgcn_ds_bpermute(pa, (int)snd.x); rcv.y = (unsigned)__builtin_amdgcn_ds_bpermute(pa, (int)snd.y);
        const u32x4 o = odd ? (u32x4){rcv.x, rcv.y, mine1.x, mine1.y} : (u32x4){mine0.x, mine0.y, rcv.x, rcv.y};
        const int d = odd ? (2 * tp + 1) * 16 + (quad - 1) * 4 : (2 * tp) * 16 + quad * 4;
        __builtin_amdgcn_raw_buffer_store_b128(o, rs, base_byte + d * 2, 0, 0); }
}
#define LDS_WAIT() asm volatile("s_waitcnt lgkmcnt(0)" ::: "memory")

__device__ __forceinline__ void flag_arrive(unsigned* cnt);
__device__ __forceinline__ void flag_arrive_wt(unsigned* cnt);
__device__ __forceinline__ void flag_wait_nf(unsigned* cnt, unsigned target, unsigned* bar);
__device__ __forceinline__ void flag_wait(unsigned* cnt, unsigned target, unsigned* bar);
namespace pg8 {
constexpr int BM = 256, BK = 64, HALF = 128, HTB = HALF * BK * 2;
__device__ __forceinline__ int lds_byte(int r, int c) { const int st = (r >> 4) * 2 + (c >> 5), rr = r & 15, cc = c & 31, ob = rr * 64 + cc * 2; return st * 1024 + (ob ^ (((ob >> 9) & 1) << 5)); }
__device__ __forceinline__ void stage_rc(int b, int& R, int& C) { const int st = b / 1024, sb = b % 1024, swz = sb ^ (((sb >> 9) & 1) << 5); R = (st >> 1) * 16 + swz / 64; C = (st & 1) * 32 + (swz % 64) / 2; }
__device__ __forceinline__ int perm32(int rho) { const int n = rho >> 4, i = rho & 15; return 8 * (i >> 2) + 4 * n + (i & 3); }

struct UD { const char* A; const char* B; int nt, kind, pm, pn, aux; };

template <class Epi, class Sched, bool ALIGN_EPI, bool AFTER_DRAIN = false>
__device__ __forceinline__ void gemm_phase(LAS unsigned char* lds, const int lda2, const int ldb2, const Sched& S, const Epi& E) {
    const int tid = tid_(), wid = __builtin_amdgcn_readfirstlane(tid >> 6), lane = tid & 63, wr = wid >> 2, wc = wid & 3, fr = lane & 15, fq = lane >> 4;
    unsigned voffA[2], voffB[2];
#pragma unroll
    for (int i = 0; i < 2; ++i) { int R, C; stage_rc(tid * 16 + i * 8192, R, C); const int Rb = Epi::PERM ? ((R & ~31) + perm32(R & 31)) : R;
        voffA[i] = (unsigned)(R * lda2 + C * 2); voffB[i] = (unsigned)(Rb * ldb2 + C * 2); }
    const size_t kstep = (size_t)(BK * 2);
    const size_t hA = (size_t)HALF * lda2, hB = (size_t)HALF * ldb2;
    const unsigned ldsw = (unsigned)wid * 1024u;
    const int aoff = lds_byte(wr * 64 + fr, fq * 8), boff = lds_byte(wc * 32 + fr, fq * 8);
#define PG8_SA(b, h) (((b) * 2 + (h)) * HTB)
#define PG8_SB(b, h) ((4 + (b) * 2 + (h)) * HTB)
#define PG8_STAGE(bufoff, gbase, voff) do { _Pragma("unroll") for (int _i = 0; _i < 2; ++_i) \
        __builtin_amdgcn_global_load_lds((const unsigned*)((const char*)(gbase) + (voff)[_i]), (LAS unsigned*)(lds + (bufoff) + ldsw + _i * 8192), 16, 0, 0); } while (0)
#define PG8_LDA(dst, b, h) do { _Pragma("unroll") for (int m = 0; m < 4; ++m) _Pragma("unroll") for (int k = 0; k < 2; ++k) dst[m][k] = *(const LAS bf16x8*)(lds + PG8_SA(b, h) + aoff + m * 2048 + k * 1024); } while (0)
#define PG8_LDB(dst, b, h) do { _Pragma("unroll") for (int n = 0; n < 2; ++n) _Pragma("unroll") for (int k = 0; k < 2; ++k) dst[n][k] = *(const LAS bf16x8*)(lds + PG8_SB(b, h) + boff + n * 2048 + k * 1024); } while (0)
#define PG8_MMA(ai, bj, At, Bt) do { __builtin_amdgcn_s_setprio(1); _Pragma("unroll") for (int m = 0; m < 4; ++m) _Pragma("unroll") for (int n = 0; n < 2; ++n) _Pragma("unroll") for (int k = 0; k < 2; ++k) \
        acc[ai][bj][m][n] = __builtin_amdgcn_mfma_f32_16x16x32_bf16(Bt[n][k], At[m][k], acc[ai][bj][m][n], 0, 0, 0); __builtin_amdgcn_s_setprio(0); } while (0)
#define PG8_WAIT_V(n) asm volatile("s_waitcnt vmcnt(" #n ")" ::: "memory")
#define PG8_WAIT_L(n) asm volatile("s_waitcnt lgkmcnt(" #n ")" ::: "memory")
#define PG8_BAR __builtin_amdgcn_s_barrier()
#define PG8_SCHED __builtin_amdgcn_sched_barrier(0)
    UD cur, nxt; int ui = 0;
    if (!S.next(0, cur)) return;
    f32x4 acc[2][2][4][2];
#pragma unroll
    for (int a = 0; a < 2; ++a)
#pragma unroll
        for (int b = 0; b < 2; ++b)
#pragma unroll
            for (int m = 0; m < 4; ++m)
#pragma unroll
                for (int n = 0; n < 2; ++n) acc[a][b][m][n] = (f32x4){0.f, 0.f, 0.f, 0.f};
    bf16x8 At[4][2], B0[2][2], B1[2][2];
    const char* cA = cur.A; const char* cB = cur.B;
    PG8_STAGE(PG8_SB(0, 0), cB, voffB); PG8_STAGE(PG8_SB(0, 1), cB + hB, voffB); PG8_STAGE(PG8_SA(0, 0), cA, voffA); PG8_STAGE(PG8_SA(0, 1), cA + hA, voffA);
    if (wr == 1) PG8_BAR;
    PG8_WAIT_V(2); PG8_BAR;
    PG8_STAGE(PG8_SB(1, 0), cB + kstep, voffB); PG8_STAGE(PG8_SA(1, 0), cA + kstep, voffA); PG8_STAGE(PG8_SB(1, 1), cB + hB + kstep, voffB);
    PG8_WAIT_V(6); PG8_BAR;
    for (;;) {
        const bool has_next = S.next(ui + 1, nxt);
        const char* nA = has_next ? nxt.A : cA; const char* nB = has_next ? nxt.B : cB;
        const int nt = cur.nt;
        for (int t = 0; t < nt; t += 2) {
            const bool last = (t == nt - 2);
            const char* a1 = cA + (size_t)(t + 1) * kstep;
            const char* a2 = last ? nA : cA + (size_t)(t + 2) * kstep; const char* b2 = last ? nB : cB + (size_t)(t + 2) * kstep;
            const char* a3 = a2 + kstep; const char* b3 = b2 + kstep;
            PG8_LDB(B0, 0, 0); PG8_LDB(B1, 0, 1); PG8_SCHED; PG8_LDA(At, 0, 0); PG8_STAGE(PG8_SA(1, 1), a1 + hA, voffA);
            PG8_WAIT_V(8); PG8_WAIT_L(0); PG8_BAR; PG8_MMA(0, 0, At, B0); PG8_MMA(0, 1, At, B1); PG8_BAR; PG8_SCHED;
            PG8_LDA(At, 0, 1); PG8_STAGE(PG8_SB(0, 0), b2, voffB); PG8_STAGE(PG8_SB(0, 1), b2 + hB, voffB); PG8_STAGE(PG8_SA(0, 0), a2, voffA);
            PG8_WAIT_V(8); PG8_WAIT_L(0); PG8_BAR; PG8_MMA(1, 0, At, B0); PG8_MMA(1, 1, At, B1); PG8_BAR; PG8_SCHED;
            PG8_LDB(B0, 1, 0); PG8_LDB(B1, 1, 1); PG8_SCHED; PG8_LDA(At, 1, 0); PG8_STAGE(PG8_SA(0, 1), a2 + hA, voffA);
            PG8_WAIT_V(8); PG8_WAIT_L(0); PG8_BAR; PG8_MMA(0, 0, At, B0); PG8_MMA(0, 1, At, B1); PG8_BAR; PG8_SCHED;
            PG8_LDA(At, 1, 1); PG8_STAGE(PG8_SB(1, 0), b3, voffB); PG8_STAGE(PG8_SB(1, 1), b3 + hB, voffB); PG8_STAGE(PG8_SA(1, 0), a3, voffA);
            PG8_WAIT_V(8); PG8_WAIT_L(0); PG8_BAR; PG8_MMA(1, 0, At, B0); PG8_MMA(1, 1, At, B1); PG8_BAR; PG8_SCHED;
        }
        if constexpr (ALIGN_EPI) { if (wr == 0) PG8_BAR; }
        bool zero = false;
        if (!AFTER_DRAIN || has_next) zero = E(acc, cur, wr, wc, fr, fq);
        if (!has_next) break;
        if (zero) {
#pragma unroll
            for (int a = 0; a < 2; ++a)
#pragma unroll
                for (int b = 0; b < 2; ++b)
#pragma unroll
                    for (int m = 0; m < 4; ++m)
#pragma unroll
                        for (int n = 0; n < 2; ++n) acc[a][b][m][n] = (f32x4){0.f, 0.f, 0.f, 0.f};
        }
        cur = nxt; cA = nA; cB = nB; ++ui;
        if constexpr (ALIGN_EPI) { if (wr == 1) PG8_BAR; }
    }
    PG8_WAIT_V(0);
    if constexpr (!ALIGN_EPI) { if (wr == 0) PG8_BAR; }
    PG8_BAR;
    if constexpr (AFTER_DRAIN) E.fused(acc, cur, wr, wc, fr, fq, lds);
#undef PG8_SA
#undef PG8_SB
#undef PG8_STAGE
#undef PG8_LDA
#undef PG8_LDB
#undef PG8_MMA
#undef PG8_WAIT_V
#undef PG8_WAIT_L
#undef PG8_BAR
#undef PG8_SCHED
}
}
using pg8::UD;

struct EpiP1 {
    static constexpr bool PERM = true;
    bf16_t* O; int ldc;
    __device__ __forceinline__ bool operator()(const f32x4 (&acc)[2][2][4][2], const UD& u, int wr, int wc, int fr, int fq) const {
        const int row0 = u.pm * 256 + wr * 64 + fr, col0 = u.pn * 256 + wc * 32 + 8 * fq;
        const __amdgpu_buffer_rsrc_t rs = __builtin_amdgcn_make_buffer_rsrc((void*)O, 0, 0x7fffffff, 0x00020000);
        const int voff = (row0 * ldc + col0) * 2;
#pragma unroll
        for (int ai = 0; ai < 2; ++ai)
#pragma unroll
            for (int m = 0; m < 4; ++m) {
#pragma unroll
                for (int bj = 0; bj < 2; ++bj) { const f32x4 v0 = acc[ai][bj][m][0], v1 = acc[ai][bj][m][1]; u32x4 w;
                    w.x = cvt_pk_bf16(v0[0], v0[1]); w.y = cvt_pk_bf16(v0[2], v0[3]); w.z = cvt_pk_bf16(v1[0], v1[1]); w.w = cvt_pk_bf16(v1[2], v1[3]);
                    __builtin_amdgcn_raw_buffer_store_b128(w, rs, voff, ((ai * 128 + m * 16) * ldc + bj * 128) * 2, 16); } }
        return true;
    }
};
struct SchedP1 {
    const char* A; const char* W; int c;
    __device__ __forceinline__ bool next(int i, UD& u) const {
        if (i >= 5) return false;
        const int xcd = c & 7, j = c >> 3, idx = i * 32 + j, pn = idx >> 3, pm = xcd * 8 + (idx & 7);
        u.A = A + (size_t)pm * 256 * 2048; u.B = W + (size_t)pn * 256 * 2048; u.nt = 16; u.kind = 0; u.pm = pm; u.pn = pn; u.aux = 0; return true;
    }
};
struct SchedKV {
    const char* memb; const char* wkv; int c;
    __device__ __forceinline__ bool next(int i, UD& u) const {
        if (i >= 1 || c >= 16) return false;
        const int lay = c >> 3, pm = (c & 7) >> 2, pn = c & 3;
        u.A = memb + (size_t)pm * 256 * 2048; u.B = wkv + (size_t)lay * 2 * MiB + (size_t)pn * 256 * 2048; u.nt = 16; u.kind = 1; u.pm = pm; u.pn = pn; u.aux = lay; return true;
    }
};
struct EpiP3G {
    static constexpr bool PERM = true;
    unsigned char* gs;
    __device__ __forceinline__ bool operator()(const f32x4 (&acc)[2][2][4][2], const UD& u, int wr, int wc, int fr, int fq) const {
        unsigned char* t = gs + (size_t)u.aux * 131072; const unsigned lo16 = (unsigned)tid_() * 16u;
#pragma unroll
        for (int ai = 0; ai < 2; ++ai)
#pragma unroll
            for (int bj = 0; bj < 2; ++bj)
#pragma unroll
                for (int m = 0; m < 4; ++m) { const int ci = (ai * 2 + bj) * 4 + m; float g[8];
#pragma unroll
                    for (int e = 0; e < 8; ++e) g[e] = fminf(1.0f + __expf(-acc[ai][bj][m][e >> 2][e & 3]), 1e9f);
                    u32x4 w; w.x = cvt_pk_bf16(g[0], g[1]); w.y = cvt_pk_bf16(g[2], g[3]); w.z = cvt_pk_bf16(g[4], g[5]); w.w = cvt_pk_bf16(g[6], g[7]);
                    *(u32x4*)(t + ci * 8192 + lo16) = w; }
        return true;
    }
};
struct SchedP3G {
    const char* xn; const char* wg; int c;
    __device__ __forceinline__ bool next(int i, UD& u) const {
        if (i >= 4) return false;
        const int pm = 8 * (c & 7) + ((c >> 3) >> 2), pn = (c >> 3) & 3; u.pm = pm; u.pn = pn;
        u.A = xn + (size_t)pm * 256 * 2048; u.B = wg + (size_t)(i * 1024 + pn * 256) * 2048; u.nt = 16; u.kind = 2; u.aux = i; return true;
    }
};
struct EpiP3B {
    static constexpr bool PERM = true;
    unsigned char* gs; bf16_t* merged;
    __device__ __forceinline__ bool operator()(f32x4 (&acc)[2][2][4][2], const UD& u, int wr, int wc, int fr, int fq) const {
        const int n = u.aux; const bool fin = (n == 3);
        const __amdgpu_buffer_rsrc_t rs = __builtin_amdgcn_make_buffer_rsrc((void*)gs, 0, 0x7fffffff, 0x00020000);
        const int s0 = n * 131072, s1 = (fin ? 3 : n + 1) * 131072; const int lo16 = (int)tid_() * 16;
#pragma unroll
        for (int ai = 0; ai < 2; ++ai)
#pragma unroll
            for (int bj = 0; bj < 2; ++bj)
#pragma unroll
                for (int m = 0; m < 4; ++m) { const int ci = (ai * 2 + bj) * 4 + m;
                    const u32x4 ga = __builtin_amdgcn_raw_buffer_load_b128(rs, lo16, s0 + ci * 8192, 0);
                    u32x4 gb = __builtin_amdgcn_raw_buffer_load_b128(rs, lo16, s1 + ci * 8192, 0);
                    if (fin) gb = (u32x4){0x3f803f80u, 0x3f803f80u, 0x3f803f80u, 0x3f803f80u};
                    f32x4 v0 = acc[ai][bj][m][0], v1 = acc[ai][bj][m][1];
                    v0[0] *= bf_lo(gb.x) * rcp_(bf_lo(ga.x)); v0[1] *= bf_hi(gb.x) * rcp_(bf_hi(ga.x));
                    v0[2] *= bf_lo(gb.y) * rcp_(bf_lo(ga.y)); v0[3] *= bf_hi(gb.y) * rcp_(bf_hi(ga.y));
                    v1[0] *= bf_lo(gb.z) * rcp_(bf_lo(ga.z)); v1[1] *= bf_hi(gb.z) * rcp_(bf_hi(ga.z));
                    v1[2] *= bf_lo(gb.w) * rcp_(bf_lo(ga.w)); v1[3] *= bf_hi(gb.w) * rcp_(bf_hi(ga.w));
                    acc[ai][bj][m][0] = v0; acc[ai][bj][m][1] = v1; }
        if (!fin) return false;
        const int row0 = wr * 64 + fr, col0 = wc * 32 + 8 * fq;
#pragma unroll
        for (int ai = 0; ai < 2; ++ai)
#pragma unroll
            for (int m = 0; m < 4; ++m) {
#pragma unroll
                for (int bj = 0; bj < 2; ++bj) { const f32x4 v0 = acc[ai][bj][m][0], v1 = acc[ai][bj][m][1]; u32x4 w;
                    w.x = cvt_pk_bf16(v0[0], v0[1]); w.y = cvt_pk_bf16(v0[2], v0[3]); w.z = cvt_pk_bf16(v1[0], v1[1]); w.w = cvt_pk_bf16(v1[2], v1[3]);
                    __builtin_amdgcn_raw_buffer_store_b128(w, rs, (row0 * 256 + col0) * 2, ((ai * 128 + m * 16) * 256 + bj * 128) * 2, 16); } }
        return true;
    }
};
struct SchedP3B {
    const char* y; const char* wb; int c;
    __device__ __forceinline__ bool next(int i, UD& u) const {
        if (i >= 4) return false;
        const int pm = 8 * (c & 7) + ((c >> 3) >> 2), pn = (c >> 3) & 3; u.pm = pm; u.pn = pn;
        u.A = y + (size_t)(i >> 1) * 32 * MiB + (size_t)pm * 256 * 2048 + (size_t)(i & 1) * 1024; u.B = wb + (size_t)i * 2 * MiB + (size_t)pn * 256 * 2048; u.nt = 8; u.kind = 3; u.aux = i; return true;
    }
};
struct EpiP4 {
    static constexpr bool PERM = false;
    const float* xres; float* out; bf16_t* xn; const float* gam; const float* bet; float* stats; unsigned* cnt; unsigned* bar;
    __device__ __forceinline__ bool operator()(const f32x4 (&acc)[2][2][4][2], const UD& u, int wr, int wc, int fr, int fq) const { return false; }
    __device__ __forceinline__ void fused(f32x4 (&acc)[2][2][4][2], const UD& u, int wr, int wc, int fr, int fq, LAS unsigned char* lds) const {
        const int tid = tid_(), lane = tid & 63;
        LAS float* PS = (LAS float*)lds;
        LAS float* RS = (LAS float*)(lds + 8192);
        const int row0 = u.pm * 256 + wr * 64 + fr, col0 = u.pn * 256 + wc * 32 + 4 * fq;
#pragma unroll
        for (int ai = 0; ai < 2; ++ai)
#pragma unroll
            for (int m = 0; m < 4; ++m) { const unsigned off = (unsigned)((row0 + ai * 128 + m * 16) * DM + col0); float sm = 0.f, sq = 0.f;
#pragma unroll
                for (int bj = 0; bj < 2; ++bj)
#pragma unroll
                    for (int n = 0; n < 2; ++n) { const f32x4 xv = *(const f32x4*)(xres + (off + (unsigned)(bj * 128 + n * 16)));
                        const f32x4 v = xv * DN_ALPHA + acc[ai][bj][m][n]; acc[ai][bj][m][n] = v;
                        sm += (v[0] + v[1]) + (v[2] + v[3]); sq += (v[0] * v[0] + v[1] * v[1]) + (v[2] * v[2] + v[3] * v[3]); }
                sm += bperm((lane ^ 16) << 2, sm); sm += bperm((lane ^ 32) << 2, sm); sq += bperm((lane ^ 16) << 2, sq); sq += bperm((lane ^ 32) << 2, sq);
                if (fq == 0) { const int rl = ai * 128 + wr * 64 + m * 16 + fr; PS[(rl * 4 + wc) * 2] = sm; PS[(rl * 4 + wc) * 2 + 1] = sq; }
                if (m & 1) asm volatile("" ::: "memory"); }
        __syncthreads();
        if (tid < 256) { const f32x4 p0 = *(const LAS f32x4*)(PS + tid * 8), p1 = *(const LAS f32x4*)(PS + tid * 8 + 4);
            float* st = stats + ((size_t)(u.pm * 256 + tid) * 4 + u.pn) * 2; const float s_ = (p0[0] + p0[2]) + (p1[0] + p1[2]), q_ = (p0[1] + p0[3]) + (p1[1] + p1[3]);
            __hip_atomic_store((unsigned long long*)st, ((unsigned long long)__float_as_uint(q_) << 32) | __float_as_uint(s_), __ATOMIC_RELAXED, __HIP_MEMORY_SCOPE_AGENT); }
        flag_arrive_wt(cnt);
        flag_wait_nf(cnt, 4u, bar);
        if (tid < 256) { const unsigned long long* st = (const unsigned long long*)(stats + (size_t)(u.pm * 256 + tid) * 8);
            float ssum = 0.f, qsum = 0.f;
#pragma unroll
            for (int k = 0; k < 4; ++k) { const unsigned long long w_ = __hip_atomic_load(st + k, __ATOMIC_RELAXED, __HIP_MEMORY_SCOPE_AGENT); ssum += __uint_as_float((unsigned)w_); qsum += __uint_as_float((unsigned)(w_ >> 32)); }
            const float mean = ssum * (1.0f / DM); const float var = qsum * (1.0f / DM) - mean * mean;
            RS[tid * 2] = mean; RS[tid * 2 + 1] = 1.0f / sqrtf(fmaxf(var, 0.f) + LN_EPS); }
        __syncthreads();
#pragma unroll
        for (int bj = 0; bj < 2; ++bj)
#pragma unroll
            for (int n = 0; n < 2; ++n) { const int cc = col0 + bj * 128 + n * 16; const f32x4 gv = *(const f32x4*)(gam + cc), bv = *(const f32x4*)(bet + cc);
#pragma unroll
                for (int ai = 0; ai < 2; ++ai)
#pragma unroll
                    for (int m = 0; m < 4; ++m) { const int rl = ai * 128 + wr * 64 + m * 16 + fr; const float mean = RS[rl * 2], rstd = RS[rl * 2 + 1];
                        const unsigned off = (unsigned)((u.pm * 256 + rl) * DM + cc);
                        const f32x4 y = (acc[ai][bj][m][n] - mean) * rstd * gv + bv; st_wt16(mk_rsrc(out), (int)(off * 4u), __builtin_bit_cast(u32x4, y));
                        if (xn) { u32x2 pk; pk.x = cvt_pk_bf16(y[0], y[1]); pk.y = cvt_pk_bf16(y[2], y[3]); st_wt8(mk_rsrc(xn), (int)(off * 2u), pk); } } }
    }
};
struct SchedP4 {
    const char* gscr; const char* wo; int c;
    __device__ __forceinline__ bool next(int i, UD& u) const {
        if (i >= 4) return false;
        const int pm = 8 * (c & 7) + ((c >> 3) >> 2), pn = (c >> 3) & 3; u.pm = pm; u.pn = pn;
        const int owner = (pm >> 3) + 8 * (((pm & 7) << 2) + i);
        u.A = gscr + (size_t)owner * 4 * 131072; u.B = wo + (size_t)pn * 256 * 2048 + (size_t)i * 512; u.nt = 4; u.kind = 4; u.aux = i; return true;
    }
};

__device__ __forceinline__ unsigned f2bf(float f) { unsigned u = __builtin_bit_cast(unsigned, f); return (u + 0x7fffu + ((u >> 16) & 1u)) >> 16; }
__device__ __forceinline__ unsigned pk2(float lo, float hi) { return f2bf(lo) | (f2bf(hi) << 16); }
__device__ __forceinline__ void transpose_item(const float* W, int K, int N, bf16_t* WT, int pitch, LAS float* scr, int item, int lane) {
    const int nblk = N / 32, kb = item / nblk, nb = item % nblk, k0 = 64 * kb, n0 = 32 * nb;
    float tv[32];
#pragma unroll
    for (int i = 0; i < 32; ++i) { const int kk = 2 * i + (lane >> 5); tv[i] = W[(size_t)(k0 + kk) * N + n0 + (lane & 31)]; }
#pragma unroll
    for (int i = 0; i < 32; ++i) { const int kk = 2 * i + (lane >> 5); scr[kk * 33 + (lane & 31)] = tv[i]; }
    LDS_WAIT();
    const int c = lane & 7;
#pragma unroll
    for (int j = 0; j < 4; ++j) { const int n = (lane >> 3) + 8 * j; const LAS float* s = scr + (8 * c) * 33 + n;
        u32x4 o; o.x = pk2(s[0 * 33], s[1 * 33]); o.y = pk2(s[2 * 33], s[3 * 33]); o.z = pk2(s[4 * 33], s[5 * 33]); o.w = pk2(s[6 * 33], s[7 * 33]);
        *(u32x4*)(WT + (size_t)(n0 + n) * pitch + k0 + 8 * c) = o; }
    LDS_WAIT();
}

struct Args {
    const float* x; const float* mem; const float* w_in; const float* w_pool; const float* pool_scale; const float* conv_w; const float* conv_b;
    const float* w_rg; const float* b_rg; const float* w_ig; const float* b_ig; const float* lru_L; const float* w_mem_kv; const float* w_branch;
    const float* w_out; const float* ln_g; const float* ln_b; float* out; unsigned char* ws;
};

__device__ __forceinline__ void sb_unit(LAS unsigned char* lds, const bf16_t* __restrict__ P, bf16_t* __restrict__ Y01, const int h, const int i) {
    const int tid = tid_(), lane = tid & 63, w = __builtin_amdgcn_readfirstlane(tid >> 6), ql = lane & 15, quad = lane >> 4;
    LAS bf16_t* Ks = (LAS bf16_t*)lds;
    LAS bf16_t* Vs = Ks + 128 * 136;
    const LAS bf16_t* vtr = Vs + (quad * 4 + (ql >> 2)) * 144 + 4 * (ql & 3);
    const int qloc = w * 16 + ql; const size_t qrow = (size_t)i * 128 + qloc;
    const float scale2 = 0.08838834764831845f * 1.4426950408889634f;
    bf16x8 qf[4];
#pragma unroll
    for (int ks = 0; ks < 4; ++ks) qf[ks] = *(const bf16x8*)(P + qrow * PW + h * 128 + ks * 32 + quad * 8);
    f32x4 o[8]; u32x2 gq[8];
#pragma unroll
    for (int d = 0; d < 8; ++d) { o[d] = (f32x4){0.f, 0.f, 0.f, 0.f}; gq[d] = *(const u32x2*)(P + qrow * PW + 1536 + h * 128 + d * 16 + quad * 4); }
    float later = 0.f; int wdone = 0;
    u32x4 kreg[4], vreg[4];
#define SB_LOAD(JJ) do { _Pragma("unroll") for (int q_ = 0; q_ < 4; ++q_) { const int c_ = tid + q_ * 512, r_ = c_ >> 4, cc_ = c_ & 15; \
            const bf16_t* kp_ = P + ((size_t)(JJ) * 128 + r_) * PW + 512 + h * 128 + cc_ * 8; kreg[q_] = *(const u32x4*)kp_; vreg[q_] = *(const u32x4*)(kp_ + 512); } } while (0)
    SB_LOAD(i);
    __syncthreads();
    for (int j = i; ; --j) {
#pragma unroll
        for (int q = 0; q < 4; ++q) { const int c = tid + q * 512, r = c >> 4, cc = c & 15; *(LAS u32x4*)(Ks + r * 136 + cc * 8) = kreg[q]; *(LAS u32x4*)(Vs + r * 144 + cc * 8) = vreg[q]; }
        __syncthreads();
        if (j > 0) SB_LOAD(j - 1);
        if (!wdone) {
            const bool diag = (j == i);
            float R = later;
#pragma unroll
            for (int p = 3; p >= 0; --p) {
                if (!wdone && !(diag && 2 * p > w)) {
                    f32x4 s0 = (f32x4){0.f, 0.f, 0.f, 0.f}, s1 = (f32x4){0.f, 0.f, 0.f, 0.f};
                    __builtin_amdgcn_s_setprio(1);
#pragma unroll
                    for (int ks = 0; ks < 4; ++ks) {
                        const bf16x8 a0 = *(const LAS bf16x8*)(Ks + ((2 * p) * 16 + ql) * 136 + ks * 32 + quad * 8);
                        const bf16x8 a1 = *(const LAS bf16x8*)(Ks + ((2 * p + 1) * 16 + ql) * 136 + ks * 32 + quad * 8);
                        s0 = __builtin_amdgcn_mfma_f32_16x16x32_bf16(a0, qf[ks], s0, 0, 0, 0); s1 = __builtin_amdgcn_mfma_f32_16x16x32_bf16(a1, qf[ks], s1, 0, 0, 0); }
                    __builtin_amdgcn_s_setprio(0);
                    unsigned pw[4];
#pragma unroll
                    for (int hh = 1; hh >= 0; --hh) { const int kt = 2 * p + hh; const f32x4 sv = hh ? s1 : s0;
                        float l1[4], ls[4]; bool vd[4];
#pragma unroll
                        for (int e = 0; e < 4; ++e) { const float z = sv[e] * scale2; const float t = __builtin_amdgcn_logf(1.0f + __builtin_amdgcn_exp2f(-fabsf(z)));
                            vd[e] = !diag || (kt * 16 + quad * 4 + e < qloc);
                            const float nsp = -(fmaxf(z, 0.f) + t);
                            l1[e] = vd[e] ? nsp : 0.f; ls[e] = z + nsp; }
                        const float sl = (l1[0] + l1[1]) + (l1[2] + l1[3]);
                        const float x1 = bperm((lane ^ 16) << 2, sl); const float s1 = sl + x1;
                        const float y = bperm((lane ^ 32) << 2, s1);
                        const float gt = (((quad & 1) == 0) ? x1 : 0.f) + (((quad & 2) == 0) ? y : 0.f);
                        const float T = s1 + y;
                        const float w3 = R + gt, w2 = w3 + l1[3], w1 = w2 + l1[2], w0 = w1 + l1[1];
                        const float p0 = vd[0] ? __builtin_amdgcn_exp2f(ls[0] + w0) : 0.f, p1 = vd[1] ? __builtin_amdgcn_exp2f(ls[1] + w1) : 0.f;
                        const float p2 = vd[2] ? __builtin_amdgcn_exp2f(ls[2] + w2) : 0.f, p3 = vd[3] ? __builtin_amdgcn_exp2f(ls[3] + w3) : 0.f;
                        pw[hh * 2] = cvt_pk_bf16(p0, p1); pw[hh * 2 + 1] = cvt_pk_bf16(p2, p3);
                        R += T; }
                    const u32x4 pv = (u32x4){pw[0], pw[1], pw[2], pw[3]};
                    __builtin_amdgcn_s_setprio(1);
#pragma unroll
                    for (int dt = 0; dt < 8; ++dt) {
                        const u32x2 lo = lds_tr16(vtr + (2 * p) * 16 * 144 + dt * 16);
                        const u32x2 hi = lds_tr16(vtr + (2 * p + 1) * 16 * 144 + dt * 16);
                        const u32x4 av = (u32x4){lo.x, lo.y, hi.x, hi.y};
                        o[dt] = __builtin_amdgcn_mfma_f32_16x16x32_bf16(__builtin_bit_cast(bf16x8, av), __builtin_bit_cast(bf16x8, pv), o[dt], 0, 0, 0); }
                    __builtin_amdgcn_s_setprio(0);
                    wdone = __all(R < -150.05f) ? 1 : 0;
                }
            }
            later = R;
        }
        if (__syncthreads_and(wdone) || j == 0) break;
    }
    u32x2 rr[8];
#pragma unroll
    for (int dt = 0; dt < 8; ++dt) { const u32x2 g = gq[dt];
        rr[dt].x = cvt_pk_bf16(o[dt][0] * siluf_(bf_lo(g.x)), o[dt][1] * siluf_(bf_hi(g.x))); rr[dt].y = cvt_pk_bf16(o[dt][2] * siluf_(bf_lo(g.y)), o[dt][3] * siluf_(bf_hi(g.y))); }
    store_row_tiles(mk_rsrc(Y01), (int)((qrow * 1024 + h * 128) * 2), rr, lane, quad);
}

__device__ __forceinline__ void xa_stage(LAS unsigned char* lds, const bf16_t* __restrict__ KV  , const int h) {
    const int tid = tid_();
    LAS bf16_t* Kms = (LAS bf16_t*)lds;
    LAS bf16_t* Vm = Kms + 256 * 136;
    for (int c = tid; c < 4096; c += 512) { const int r = c >> 4, cc = c & 15;
        const bf16_t* kp = KV + (size_t)r * 1024 + h * 128 + cc * 8;
        *(LAS u32x4*)(Kms + r * 136 + cc * 8) = *(const u32x4*)kp; *(LAS u32x4*)(Vm + r * 144 + cc * 8) = *(const u32x4*)(kp + 512); }
}
__device__ __forceinline__ void xa_tile(LAS unsigned char* lds, const bf16_t* __restrict__ P, bf16_t* __restrict__ Y23, const int h, const int tile) {
    const int tid = tid_(), lane = tid & 63, w = tid >> 6, ql = lane & 15, quad = lane >> 4;
    const LAS bf16_t* Kms = (const LAS bf16_t*)lds;
    const LAS bf16_t* vtr = Kms + 256 * 136 + (quad * 4 + (ql >> 2)) * 144 + 4 * (ql & 3);
    const size_t qrow = (size_t)tile * 128 + w * 16 + ql;
    const float scale = 0.08838834764831845f;
    bf16x8 qf[4];
#pragma unroll
    for (int ks = 0; ks < 4; ++ks) qf[ks] = *(const bf16x8*)(P + qrow * PW + 4096 + h * 128 + ks * 32 + quad * 8);
    f32x4 s[16];
    __builtin_amdgcn_s_setprio(1);
#pragma unroll
    for (int kt = 0; kt < 16; ++kt) { s[kt] = (f32x4){0.f, 0.f, 0.f, 0.f};
#pragma unroll
        for (int ks = 0; ks < 4; ++ks) { const bf16x8 a = *(const LAS bf16x8*)(Kms + (kt * 16 + ql) * 136 + ks * 32 + quad * 8);
            s[kt] = __builtin_amdgcn_mfma_f32_16x16x32_bf16(a, qf[ks], s[kt], 0, 0, 0); } }
    __builtin_amdgcn_s_setprio(0);
    float m = -3.0e38f;
#pragma unroll
    for (int kt = 0; kt < 16; ++kt)
#pragma unroll
        for (int e = 0; e < 4; ++e) m = fmaxf(m, s[kt][e]);
    m = fmaxf(m, bperm((lane ^ (16)) << 2, m)); m = fmaxf(m, bperm((lane ^ (32)) << 2, m));
    float sum = 0.f; unsigned pw[32];
#pragma unroll
    for (int kt = 0; kt < 16; ++kt) { float p[4];
#pragma unroll
        for (int e = 0; e < 4; ++e) { p[e] = __builtin_amdgcn_exp2f((s[kt][e] - m) * (scale * 1.4426950408889634f)); sum += p[e]; }
        pw[kt * 2] = cvt_pk_bf16(p[0], p[1]); pw[kt * 2 + 1] = cvt_pk_bf16(p[2], p[3]); }
    sum += bperm((lane ^ (16)) << 2, sum); sum += bperm((lane ^ (32)) << 2, sum);
    const float inv = 1.0f / sum;
    f32x4 o[8];
    __builtin_amdgcn_s_setprio(1);
#pragma unroll
    for (int dt = 0; dt < 8; ++dt) { o[dt] = (f32x4){0.f, 0.f, 0.f, 0.f};
#pragma unroll
        for (int ks = 0; ks < 8; ++ks) {
            const u32x2 lo = lds_tr16(vtr + (2 * ks) * 16 * 144 + dt * 16);
            const u32x2 hi = lds_tr16(vtr + (2 * ks + 1) * 16 * 144 + dt * 16);
            const u32x4 av = (u32x4){lo.x, lo.y, hi.x, hi.y};
            const u32x4 pv = (u32x4){pw[4 * ks], pw[4 * ks + 1], pw[4 * ks + 2], pw[4 * ks + 3]};
            o[dt] = __builtin_amdgcn_mfma_f32_16x16x32_bf16(__builtin_bit_cast(bf16x8, av), __builtin_bit_cast(bf16x8, pv), o[dt], 0, 0, 0); } }
    __builtin_amdgcn_s_setprio(0);
    u32x2 rr[8];
#pragma unroll
    for (int dt = 0; dt < 8; ++dt) { const int d = dt * 16 + quad * 4;
        const u32x2 g = *(const u32x2*)(P + qrow * PW + 4608 + h * 128 + d);
        rr[dt].x = cvt_pk_bf16(o[dt][0] * inv * siluf_(bf_lo(g.x)), o[dt][1] * inv * siluf_(bf_hi(g.x)));
        rr[dt].y = cvt_pk_bf16(o[dt][2] * inv * siluf_(bf_lo(g.y)), o[dt][3] * inv * siluf_(bf_hi(g.y))); }
    store_row_tiles(mk_rsrc(Y23), (int)((qrow * 1024 + 512 + h * 128) * 2), rr, lane, quad);
}

__device__ __forceinline__ void pool_stage(LAS unsigned char* lds, const bf16_t* __restrict__ Wp  ) {
    LAS bf16_t* Ws = (LAS bf16_t*)lds;
    for (int c = tid_(); c < 2048; c += 512) { const int r = c >> 4, cc = c & 15; *(LAS u32x4*)(Ws + r * 136 + cc * 8) = *(const u32x4*)(Wp + r * 128 + cc * 8); }
}
template <int WIN>
__device__ __forceinline__ void pool_tile_w(LAS unsigned char* lds, const bf16_t* __restrict__ P, bf16_t* __restrict__ Y01, const float* __restrict__ pscale, const int g, const int tile) {
    const int tid = tid_(), lane = tid & 63, w = tid >> 6, ql = lane & 15, quad = lane >> 4;
    const LAS bf16_t* Ws = (const LAS bf16_t*)lds;
    LAS bf16_t* U = (LAS bf16_t*)(lds + 34816);
    u32x2 gq[8];
#pragma unroll
    for (int jt = 0; jt < 8; ++jt) gq[jt] = *(const u32x2*)(P + (size_t)(tile * 128 + w * 16 + ql) * PW + 2560 + g * 128 + jt * 16 + quad * 4);
    __syncthreads();
    for (int c = tid; c < 143 * 16; c += 512) { const int r = c >> 4, cc = c & 15; const int grow = tile * 128 - 15 + r;
        u32x4 v = (u32x4){0u, 0u, 0u, 0u};
        if (grow >= 0) v = *(const u32x4*)(P + (size_t)grow * PW + 2048 + g * 128 + cc * 8);
        *(LAS u32x4*)(U + r * 136 + cc * 8) = v; }
    __syncthreads();
    const int pos = tile * 128 + w * 16 + ql, lrow = 15 + w * 16 + ql;
    const int cnt = (pos + 1 < WIN) ? pos + 1 : WIN; const float rc = rcp_((float)cnt);
    bf16x8 bfm[4];
#pragma unroll
    for (int ks = 0; ks < 4; ++ks) {
        const LAS bf16_t* up = U + lrow * 136 + ks * 32 + quad * 8;
        const u32x4 c0 = *(const LAS u32x4*)up;
        const float a[8] = {bf_lo(c0.x), bf_hi(c0.x), bf_lo(c0.y), bf_hi(c0.y), bf_lo(c0.z), bf_hi(c0.z), bf_lo(c0.w), bf_hi(c0.w)};
        float sm[8];
#pragma unroll
        for (int e = 0; e < 8; ++e) sm[e] = a[e];
#pragma unroll
        for (int t = 1; t < WIN; ++t) { const u32x4 c1 = *(const LAS u32x4*)(up - t * 136);
            sm[0] += bf_lo(c1.x); sm[1] += bf_hi(c1.x); sm[2] += bf_lo(c1.y); sm[3] += bf_hi(c1.y); sm[4] += bf_lo(c1.z); sm[5] += bf_hi(c1.z); sm[6] += bf_lo(c1.w); sm[7] += bf_hi(c1.w); }
        u32x4 pk; pk.x = cvt_pk_bf16(sm[0] * rc - a[0], sm[1] * rc - a[1]); pk.y = cvt_pk_bf16(sm[2] * rc - a[2], sm[3] * rc - a[3]);
        pk.z = cvt_pk_bf16(sm[4] * rc - a[4], sm[5] * rc - a[5]); pk.w = cvt_pk_bf16(sm[6] * rc - a[6], sm[7] * rc - a[7]);
        bfm[ks] = __builtin_bit_cast(bf16x8, pk);
    }
    u32x2 rr[8];
#pragma unroll
    for (int jt = 0; jt < 8; ++jt) { f32x4 acc = (f32x4){0.f, 0.f, 0.f, 0.f};
#pragma unroll
        for (int ks = 0; ks < 4; ++ks) { const bf16x8 a = *(const LAS bf16x8*)(Ws + (jt * 16 + ql) * 136 + ks * 32 + quad * 8);
            acc = __builtin_amdgcn_mfma_f32_16x16x32_bf16(a, bfm[ks], acc, 0, 0, 0); }
        const int j = g * 128 + jt * 16 + quad * 4;
        const f32x4 ps = *(const f32x4*)(pscale + j);
        const u32x2 gg = gq[jt];
        rr[jt].x = cvt_pk_bf16(acc[0] * ps[0] * siluf_(bf_lo(gg.x)), acc[1] * ps[1] * siluf_(bf_hi(gg.x)));
        rr[jt].y = cvt_pk_bf16(acc[2] * ps[2] * siluf_(bf_lo(gg.y)), acc[3] * ps[3] * siluf_(bf_hi(gg.y))); }
    store_row_tiles(mk_rsrc(Y01), (pos * 1024 + 512 + g * 128) * 2, rr, lane, quad);
}
__device__ __forceinline__ void pool_tile(LAS unsigned char* lds, const bf16_t* __restrict__ P, bf16_t* __restrict__ Y01, const float* __restrict__ pscale, const int g, const int tile) {
    if (g == 0) pool_tile_w<2>(lds, P, Y01, pscale, g, tile);
    else if (g == 1) pool_tile_w<4>(lds, P, Y01, pscale, g, tile);
    else if (g == 2) pool_tile_w<8>(lds, P, Y01, pscale, g, tile);
    else pool_tile_w<16>(lds, P, Y01, pscale, g, tile);
}

#define XB_TMO      128
#define XB_XCNT(j)  (256  + 64 * (j))
#define XB_XSUB(j)  (1280 + 64 * (j))
#define XB_XGEN(j)  (2304 + 64 * (j))
#define XB_TOP      3328
#define XB_TOPGEN   3392
#define XCD_BAR_WORDS 3456
#define XB_SPIN_CAP (1u << 22)
__device__ __forceinline__ unsigned xb_ld(unsigned* p)              { return __hip_atomic_load(p, __ATOMIC_RELAXED, __HIP_MEMORY_SCOPE_AGENT); }
__device__ __forceinline__ unsigned xb_add(unsigned* p, unsigned v) { return __hip_atomic_fetch_add(p, v, __ATOMIC_RELAXED, __HIP_MEMORY_SCOPE_AGENT); }
__device__ __forceinline__ unsigned xb_xcc_id() { return (unsigned)__builtin_amdgcn_s_getreg((3 << 11) | 20) & 0xFu; }
#define XB_SPIN(cond, bar) do { unsigned _sp = 0; while (cond) { __builtin_amdgcn_s_sleep(1); \
    if ((++_sp & 255u) == 0u) { if (xb_ld(&(bar)[XB_TMO])) break; if (_sp > XB_SPIN_CAP) { atomicAdd(&(bar)[XB_TMO], 1u); break; } } } } while (0)
__device__ __forceinline__ void xcd_barrier_complete(unsigned* bar, unsigned x, unsigned& nloc, unsigned& nx) {
    const unsigned G = gridDim.x * gridDim.y * gridDim.z;
    unsigned sum, cnt, mine, sp = 0u;
    for (;;) {
        sum = 0u; cnt = 0u; mine = 0u;
#pragma unroll
        for (unsigned j = 0; j < 16; ++j) { const unsigned c = xb_ld(&bar[XB_XCNT(j)]); sum += c; cnt += (c > 0u) ? 1u : 0u; mine = (j == x) ? c : mine; }
        if (sum == G) break;
        __builtin_amdgcn_s_sleep(1);
        if ((++sp & 255u) == 0u) { if (xb_ld(&bar[XB_TMO])) break; if (sp > XB_SPIN_CAP) { atomicAdd(&bar[XB_TMO], 1u); break; } }
    }
    nloc = mine > 0u ? mine : 1u; nx = cnt > 0u ? cnt : 1u;
}
__device__ __forceinline__ void xcd_barrier(unsigned* bar, volatile LAS unsigned* st) {
    asm volatile("s_waitcnt vmcnt(0)" ::: "memory");
    __syncthreads();
    if (tid_() == 0) {
        const unsigned x = xb_xcc_id();
        __builtin_amdgcn_s_waitcnt(0);
        unsigned nloc = st[0], nx = st[1];
        if (nloc == 0u) { xcd_barrier_complete(bar, x, nloc, nx); st[0] = nloc; st[1] = nx; }
        const unsigned old = xb_add(&bar[XB_XSUB(x)], 1u);
        const unsigned gen = old / nloc;
        if (old + 1u == (gen + 1u) * nloc) {
            __builtin_amdgcn_fence(__ATOMIC_RELEASE, "agent");
            asm volatile("s_waitcnt vmcnt(0)" ::: "memory");
            const unsigned og = xb_add(&bar[XB_TOP], 1u);
            const unsigned tg = og / nx;
            if (og + 1u == (tg + 1u) * nx) xb_add(&bar[XB_TOPGEN], 1u);
            else XB_SPIN(xb_ld(&bar[XB_TOPGEN]) == tg, bar);
            __builtin_amdgcn_fence(__ATOMIC_ACQUIRE, "agent");
            xb_add(&bar[XB_XGEN(x)], 1u);
            asm volatile("s_waitcnt vmcnt(0)" ::: "memory");
        } else {
            XB_SPIN(xb_ld(&bar[XB_XGEN(x)]) == gen, bar);
            __builtin_amdgcn_fence(__ATOMIC_ACQUIRE, "agent");
            asm volatile("s_waitcnt vmcnt(0)" ::: "memory");
        }
    }
    __syncthreads();
}


__device__ __forceinline__ void flag_arrive(unsigned* cnt) {
    asm volatile("s_waitcnt vmcnt(0)" ::: "memory"); __syncthreads();
    if (tid_() == 0) { __builtin_amdgcn_fence(__ATOMIC_RELEASE, "agent"); asm volatile("s_waitcnt vmcnt(0)" ::: "memory"); (void)xb_add(cnt, 1u); }
}
__device__ __forceinline__ void flag_wait_nf(unsigned* cnt, unsigned target, unsigned* bar) {
    if (tid_() == 0) { XB_SPIN(xb_ld(cnt) < target, bar); }
    __syncthreads();
}
__device__ __forceinline__ float ld_agent(const float* p) { return __hip_atomic_load(p, __ATOMIC_RELAXED, __HIP_MEMORY_SCOPE_AGENT); }
__device__ __forceinline__ void flag_arrive_wt(unsigned* cnt) {
    asm volatile("s_waitcnt vmcnt(0)" ::: "memory"); __syncthreads();
    if (tid_() == 0) (void)xb_add(cnt, 1u);
}
__device__ __forceinline__ void flag_wait(unsigned* cnt, unsigned target, unsigned* bar) {
    if (tid_() == 0) { XB_SPIN(xb_ld(cnt) < target, bar); __builtin_amdgcn_fence(__ATOMIC_ACQUIRE, "agent"); asm volatile("s_waitcnt vmcnt(0)" ::: "memory"); }
    __syncthreads();
}
__device__ __forceinline__ void fold4(const float* base, const int n, const int quad, const int ql, float (&Po)[4], float (&Ho)[4]) {
    const int seg = (n + 3) >> 2, i0 = quad * seg; int i1 = i0 + seg; if (i1 > n) i1 = n;
    float Ps[4] = {1.f, 1.f, 1.f, 1.f}, Hs[4] = {0.f, 0.f, 0.f, 0.f};
#pragma unroll 4
    for (int i = i0; i < i1; ++i) {
#pragma unroll
        for (int nt = 0; nt < 4; ++nt) { const float a = ld_agent(base + (size_t)i * 1024 + nt * 16), bb = ld_agent(base + (size_t)i * 1024 + 512 + nt * 16); Hs[nt] = a * Hs[nt] + bb; Ps[nt] *= a; } }
#pragma unroll
    for (int nt = 0; nt < 4; ++nt) {
        const float P0 = bperm((ql) << 2, Ps[nt]), P1 = bperm((ql + 16) << 2, Ps[nt]), P2 = bperm((ql + 32) << 2, Ps[nt]), P3 = bperm((ql + 48) << 2, Ps[nt]);
        const float H0 = bperm((ql) << 2, Hs[nt]), H1 = bperm((ql + 16) << 2, Hs[nt]), H2 = bperm((ql + 32) << 2, Hs[nt]), H3 = bperm((ql + 48) << 2, Hs[nt]);
        Po[nt] = (P0 * P1) * (P2 * P3); Ho[nt] = ((H0 * P1 + H1) * P2 + H2) * P3 + H3; }
}

__device__ __forceinline__ void lru_stage(LAS unsigned char* lds, const float* cw, const float* cb, const float* brg, const float* big, const float* L) {
    LAS float* F = (LAS float*)lds;
    for (int i = tid_(); i < 2048; i += 512) F[i] = cw[i];
    { const int i = tid_(); F[2048 + i] = cb[i]; F[2560 + i] = brg[i]; F[3072 + i] = big[i];
      const float l = -L[i]; F[3584 + i] = fmaxf(l, 0.f) + log1pf(__expf(-fabsf(l))); }
}
template <bool FINAL>
__device__ __forceinline__ void lru_unit(LAS unsigned char* lds, const bf16_t* __restrict__ P, bf16_t* __restrict__ Y23, float* __restrict__ AGG, const float* __restrict__ GAGG,
                                         const bf16_t* __restrict__ Wrg, const bf16_t* __restrict__ Wig, unsigned char* __restrict__ cache, const int tile) {
    const int tid = tid_(), lane = tid & 63, hd = tid >> 6, ql = lane & 15, quad = lane >> 4;
    const LAS float* F = (const LAS float*)lds;
    LAS float* XC = (LAS float*)(lds + 16384 + hd * 7168);
    bf16x8 wr_[4][2], wi_[4][2];
#pragma unroll
    for (int nt = 0; nt < 4; ++nt)
#pragma unroll
        for (int ks = 0; ks < 2; ++ks) { const size_t o = (size_t)(hd * 64 + nt * 16 + ql) * 64 + ks * 32 + quad * 8;
            wr_[nt][ks] = *(const bf16x8*)(Wrg + o); wi_[nt][ks] = *(const bf16x8*)(Wig + o); }
    float hst[4] = {0.f, 0.f, 0.f, 0.f}, ptot[4] = {1.f, 1.f, 1.f, 1.f};
    if (FINAL) {
        float Pa[4], Ha[4], Pb[4], Hb[4];
        fold4(GAGG + hd * 64 + ql, tile >> 4, quad, ql, Pa, Ha);
        fold4(AGG + (size_t)(tile & ~15) * 1024 + hd * 64 + ql, tile & 15, quad, ql, Pb, Hb);
#pragma unroll
        for (int nt = 0; nt < 4; ++nt) hst[nt] = Pb[nt] * Ha[nt] + Hb[nt];
    }
    const int tk = lane >> 2, cg4 = (lane & 3) * 16, cb0 = hd * 64 + cg4;
    LAS bf16_t* UB = (LAS bf16_t*)(lds + 16384 + hd * 7168 + 4352);
    u32x4 pu[3];
    const int lrow = lane >> 3, lch = (lane & 7) * 8;
#define LRU_LOADU(T0) do { const bf16_t* ub_ = P + 3072 + hd * 64 + lch; \
        pu[0] = *(const u32x4*)(ub_ + (size_t)((T0) + lrow) * PW); pu[1] = *(const u32x4*)(ub_ + (size_t)((T0) + 8 + lrow) * PW); \
        { const int p = (T0) - 3 + lrow; pu[2] = (lane < 24 && p >= 0) ? *(const u32x4*)(ub_ + (size_t)(p < 0 ? 0 : p) * PW) : (u32x4){0u, 0u, 0u, 0u}; } } while (0)
    LRU_LOADU(tile * 64);
    for (int sub = 0; sub < 4; ++sub) {
        const int t0 = tile * 64 + sub * 16;
        {
            LDS_WAIT();
            *(LAS u32x4*)(UB + (3 + lrow) * 72 + lch) = pu[0]; *(LAS u32x4*)(UB + (11 + lrow) * 72 + lch) = pu[1];
            if (lane < 24) *(LAS u32x4*)(UB + lrow * 72 + lch) = pu[2];
            LDS_WAIT();
            if (sub < 3) LRU_LOADU(t0 + 16);
            float xc[16];
#pragma unroll
            for (int e = 0; e < 16; ++e) xc[e] = F[2048 + cb0 + e];
#pragma unroll
            for (int tap = 0; tap < 4; ++tap) {
                const u32x4 u0 = *(const LAS u32x4*)(UB + (tk + tap) * 72 + cg4), u1 = *(const LAS u32x4*)(UB + (tk + tap) * 72 + cg4 + 8);
                const float uv[16] = {bf_lo(u0.x), bf_hi(u0.x), bf_lo(u0.y), bf_hi(u0.y), bf_lo(u0.z), bf_hi(u0.z), bf_lo(u0.w), bf_hi(u0.w),
                                      bf_lo(u1.x), bf_hi(u1.x), bf_lo(u1.y), bf_hi(u1.y), bf_lo(u1.z), bf_hi(u1.z), bf_lo(u1.w), bf_hi(u1.w)};
#pragma unroll
                for (int e = 0; e < 16; ++e) xc[e] += F[tap * 512 + cb0 + e] * uv[e]; }
#pragma unroll
            for (int q = 0; q < 4; ++q) *(LAS f32x4*)(XC + tk * 68 + cg4 + q * 4) = (f32x4){xc[q * 4], xc[q * 4 + 1], xc[q * 4 + 2], xc[q * 4 + 3]};
            LDS_WAIT();
        }
        bf16x8 af[2];
#pragma unroll
        for (int ks = 0; ks < 2; ++ks) { const f32x4 a0 = *(const LAS f32x4*)(XC + ql * 68 + ks * 32 + quad * 8), a1 = *(const LAS f32x4*)(XC + ql * 68 + ks * 32 + quad * 8 + 4);
            u32x4 pk; pk.x = cvt_pk_bf16(a0[0], a0[1]); pk.y = cvt_pk_bf16(a0[2], a0[3]); pk.z = cvt_pk_bf16(a1[0], a1[1]); pk.w = cvt_pk_bf16(a1[2], a1[3]);
            af[ks] = __builtin_bit_cast(bf16x8, pk); }
#pragma unroll
        for (int nt = 0; nt < 4; ++nt) {
            f32x4 ar = (f32x4){0.f, 0.f, 0.f, 0.f}, ai = (f32x4){0.f, 0.f, 0.f, 0.f};
#pragma unroll
            for (int ks = 0; ks < 2; ++ks) { ar = __builtin_amdgcn_mfma_f32_16x16x32_bf16(af[ks], wr_[nt][ks], ar, 0, 0, 0); ai = __builtin_amdgcn_mfma_f32_16x16x32_bf16(af[ks], wi_[nt][ks], ai, 0, 0, 0); }
            const int c = hd * 64 + nt * 16 + ql;
            const float brg = F[2560 + c], big = F[3072 + c], spl = F[3584 + c];
            float av[4], bv[4]; unsigned cpk[4];
#pragma unroll
            for (int e = 0; e < 4; ++e) { const float xcv = XC[(quad * 4 + e) * 68 + nt * 16 + ql];
                const float r = sigmoidf_(ar[e] + brg), ig = sigmoidf_(ai[e] + big);
                const float la = -8.0f * r * spl; const float a = __expf(la);
                const float om = fmaxf(1.0f - a * a, 0.0f);
                const unsigned pkv = cvt_pk_bf16(la, __builtin_amdgcn_sqrtf(om) * ig * xcv); cpk[e] = pkv;
                av[e] = FINAL ? a : __expf(bf_lo(pkv)); bv[e] = bf_hi(pkv); }
            if (!FINAL) *(u32x4*)(cache + ((size_t)((sub * 4 + nt) * 512 + tid)) * 16) = (u32x4){cpk[0], cpk[1], cpk[2], cpk[3]};
            const float Pq = (av[0] * av[1]) * (av[2] * av[3]);
            const float Hq = ((bv[0] * av[1] + bv[1]) * av[2] + bv[2]) * av[3] + bv[3];
            const float P0 = bperm((ql) << 2, Pq), P1 = bperm((ql + 16) << 2, Pq), P2 = bperm((ql + 32) << 2, Pq), P3 = bperm((ql + 48) << 2, Pq);
            const float H0 = bperm((ql) << 2, Hq), H1 = bperm((ql + 16) << 2, Hq), H2 = bperm((ql + 32) << 2, Hq), H3 = bperm((ql + 48) << 2, Hq);
            const float c0 = hst[nt], c1 = P0 * c0 + H0, c2 = P1 * c1 + H1, c3 = P2 * c2 + H2;
            if (FINAL) {
                float hh = quad == 0 ? c0 : (quad == 1 ? c1 : (quad == 2 ? c2 : c3));
#pragma unroll
                for (int e = 0; e < 4; ++e) { hh = av[e] * hh + bv[e]; XC[(quad * 4 + e) * 68 + nt * 16 + ql] = hh; }
            }
            hst[nt] = P3 * c3 + H3; ptot[nt] *= (P0 * P1) * (P2 * P3);
        }
        if (FINAL) {
            LDS_WAIT();
            const size_t row = (size_t)t0 + tk;
            const bf16_t* gp = P + row * PW + 3584 + cb0; const u32x4 g0 = *(const u32x4*)gp, g1 = *(const u32x4*)(gp + 8);
            const f32x4 h0 = *(const LAS f32x4*)(XC + tk * 68 + cg4), h1 = *(const LAS f32x4*)(XC + tk * 68 + cg4 + 4), h2 = *(const LAS f32x4*)(XC + tk * 68 + cg4 + 8), h3 = *(const LAS f32x4*)(XC + tk * 68 + cg4 + 12);
            u32x4 o0, o1;
            o0.x = cvt_pk_bf16(h0[0] * siluf_(bf_lo(g0.x)), h0[1] * siluf_(bf_hi(g0.x))); o0.y = cvt_pk_bf16(h0[2] * siluf_(bf_lo(g0.y)), h0[3] * siluf_(bf_hi(g0.y)));
            o0.z = cvt_pk_bf16(h1[0] * siluf_(bf_lo(g0.z)), h1[1] * siluf_(bf_hi(g0.z))); o0.w = cvt_pk_bf16(h1[2] * siluf_(bf_lo(g0.w)), h1[3] * siluf_(bf_hi(g0.w)));
            o1.x = cvt_pk_bf16(h2[0] * siluf_(bf_lo(g1.x)), h2[1] * siluf_(bf_hi(g1.x))); o1.y = cvt_pk_bf16(h2[2] * siluf_(bf_lo(g1.y)), h2[3] * siluf_(bf_hi(g1.y)));
            o1.z = cvt_pk_bf16(h3[0] * siluf_(bf_lo(g1.z)), h3[1] * siluf_(bf_hi(g1.z))); o1.w = cvt_pk_bf16(h3[2] * siluf_(bf_lo(g1.w)), h3[3] * siluf_(bf_hi(g1.w)));
            bf16_t* yp = Y23 + row * 1024 + cb0; *(u32x4*)yp = o0; *(u32x4*)(yp + 8) = o1;
        }
    }
    if (!FINAL && quad == 0) {
#pragma unroll
        for (int nt = 0; nt < 4; ++nt) { const int c = hd * 64 + nt * 16 + ql; __hip_atomic_store(AGG + (size_t)tile * 1024 + c, ptot[nt], __ATOMIC_RELAXED, __HIP_MEMORY_SCOPE_AGENT); __hip_atomic_store(AGG + (size_t)tile * 1024 + 512 + c, hst[nt], __ATOMIC_RELAXED, __HIP_MEMORY_SCOPE_AGENT); }
    }
}


__device__ __forceinline__ void lru_final(LAS unsigned char* lds, const bf16_t* __restrict__ P, bf16_t* __restrict__ Y23, const float* __restrict__ AGG, const float* __restrict__ GAGG,
                                          const unsigned char* __restrict__ cache, const int tile) {
    const int tid = tid_(), lane = tid & 63, hd = tid >> 6, ql = lane & 15, quad = lane >> 4;
    LAS float* XC = (LAS float*)(lds + hd * 4352);
    float hst[4];
    {   float Pa[4], Ha[4], Pb[4], Hb[4];
        fold4(GAGG + hd * 64 + ql, tile >> 4, quad, ql, Pa, Ha);
        fold4(AGG + (size_t)(tile & ~15) * 1024 + hd * 64 + ql, tile & 15, quad, ql, Pb, Hb);
#pragma unroll
        for (int nt = 0; nt < 4; ++nt) hst[nt] = Pb[nt] * Ha[nt] + Hb[nt]; }
    const int tk = lane >> 2, cg4 = (lane & 3) * 16, cb0 = hd * 64 + cg4;
    u32x4 pk[4];
#pragma unroll
    for (int nt = 0; nt < 4; ++nt) pk[nt] = *(const u32x4*)(cache + ((size_t)(nt * 512 + tid)) * 16);
    for (int sub = 0; sub < 4; ++sub) {
        const int t0 = tile * 64 + sub * 16;
        const size_t row = (size_t)t0 + tk;
        const bf16_t* gp = P + row * PW + 3584 + cb0; const u32x4 g0 = *(const u32x4*)gp, g1 = *(const u32x4*)(gp + 8);
        u32x4 cur[4];
#pragma unroll
        for (int nt = 0; nt < 4; ++nt) cur[nt] = pk[nt];
        if (sub < 3) {
#pragma unroll
            for (int nt = 0; nt < 4; ++nt) pk[nt] = *(const u32x4*)(cache + ((size_t)(((sub + 1) * 4 + nt) * 512 + tid)) * 16); }
        LDS_WAIT();
#pragma unroll
        for (int nt = 0; nt < 4; ++nt) {
            const unsigned cw[4] = {cur[nt].x, cur[nt].y, cur[nt].z, cur[nt].w};
            float av[4], bv[4];
#pragma unroll
            for (int e = 0; e < 4; ++e) { av[e] = __expf(bf_lo(cw[e])); bv[e] = bf_hi(cw[e]); }
            const float Pq = (av[0] * av[1]) * (av[2] * av[3]);
            const float Hq = ((bv[0] * av[1] + bv[1]) * av[2] + bv[2]) * av[3] + bv[3];
            const float P0 = bperm((ql) << 2, Pq), P1 = bperm((ql + 16) << 2, Pq), P2 = bperm((ql + 32) << 2, Pq), P3 = bperm((ql + 48) << 2, Pq);
            const float H0 = bperm((ql) << 2, Hq), H1 = bperm((ql + 16) << 2, Hq), H2 = bperm((ql + 32) << 2, Hq), H3 = bperm((ql + 48) << 2, Hq);
            const float c0 = hst[nt], c1 = P0 * c0 + H0, c2 = P1 * c1 + H1, c3 = P2 * c2 + H2;
            float hh = quad == 0 ? c0 : (quad == 1 ? c1 : (quad == 2 ? c2 : c3));
#pragma unroll
            for (int e = 0; e < 4; ++e) { hh = av[e] * hh + bv[e]; XC[(quad * 4 + e) * 68 + nt * 16 + ql] = hh; }
            hst[nt] = P3 * c3 + H3;
        }
        LDS_WAIT();
        const f32x4 h0 = *(const LAS f32x4*)(XC + tk * 68 + cg4), h1 = *(const LAS f32x4*)(XC + tk * 68 + cg4 + 4), h2 = *(const LAS f32x4*)(XC + tk * 68 + cg4 + 8), h3 = *(const LAS f32x4*)(XC + tk * 68 + cg4 + 12);
        u32x4 o0, o1;
        o0.x = cvt_pk_bf16(h0[0] * siluf_(bf_lo(g0.x)), h0[1] * siluf_(bf_hi(g0.x))); o0.y = cvt_pk_bf16(h0[2] * siluf_(bf_lo(g0.y)), h0[3] * siluf_(bf_hi(g0.y)));
        o0.z = cvt_pk_bf16(h1[0] * siluf_(bf_lo(g0.z)), h1[1] * siluf_(bf_hi(g0.z))); o0.w = cvt_pk_bf16(h1[2] * siluf_(bf_lo(g0.w)), h1[3] * siluf_(bf_hi(g0.w)));
        o1.x = cvt_pk_bf16(h2[0] * siluf_(bf_lo(g1.x)), h2[1] * siluf_(bf_hi(g1.x))); o1.y = cvt_pk_bf16(h2[2] * siluf_(bf_lo(g1.y)), h2[3] * siluf_(bf_hi(g1.y)));
        o1.z = cvt_pk_bf16(h3[0] * siluf_(bf_lo(g1.z)), h3[1] * siluf_(bf_hi(g1.z))); o1.w = cvt_pk_bf16(h3[2] * siluf_(bf_lo(g1.w)), h3[3] * siluf_(bf_hi(g1.w)));
        bf16_t* yp = Y23 + row * 1024 + cb0; *(u32x4*)yp = o0; *(u32x4*)(yp + 8) = o1;
    }
}

typedef const __attribute__((address_space(4))) Args* ArgsP;
__device__ __forceinline__ ArgsP args_ptr() { ArgsP p = (ArgsP)__builtin_amdgcn_kernarg_segment_ptr(); asm volatile("" : "+s"(p)); return p; }
__global__ void __launch_bounds__(512, 2) mk_fwd(Args a_unused) {
    extern __shared__ __attribute__((aligned(16))) unsigned char lds_[];
    LAS unsigned char* lds = (LAS unsigned char*)lds_;
    cg::grid_group grid = cg::this_grid();
    volatile LAS unsigned* bst = (volatile LAS unsigned*)(lds + LDS_BARW);
    { ArgsP ap0 = args_ptr(); unsigned* bar0 = (unsigned*)(ap0->ws);
      if (tid_() == 0) { bst[0] = 0u; bst[1] = 0u; (void)xb_add(&bar0[XB_XCNT(xb_xcc_id())], 1u); } }
#define GRID_BAR() do { ArgsP apb = args_ptr(); xcd_barrier((unsigned*)(apb->ws), bst); } while (0)

    {
        __syncthreads();
        ArgsP ap = args_ptr(); unsigned char* ws = ap->ws;
        const int tid = tid_(), lane = tid & 63, wave = __builtin_amdgcn_readfirstlane(tid >> 6), c = bid_(), G = gridDim.x;
        bf16_t* Wpool_t = (bf16_t*)(ws + WS_SMALL); bf16_t* Wrg_t = (bf16_t*)(ws + WS_SMALL + 262144); bf16_t* Wig_t = (bf16_t*)(ws + WS_SMALL + 262144 + 131072);
        bf16_t* MEMB = (bf16_t*)(ws + WS_MEMB); bf16_t* Win_t = (bf16_t*)(ws + WS_WIN); bf16_t* Wb_t = (bf16_t*)(ws + WS_WB); bf16_t* Wo_t = (bf16_t*)(ws + WS_WO); bf16_t* Wkv_t = (bf16_t*)(ws + WS_WKV);
        bf16_t* XN = (bf16_t*)(ws + WS_XN);
        LAS float* scr = (LAS float*)(lds + wave * 16384);
        const int gw = c * 8 + wave, NGW = G * 8;
        constexpr int I_IN = 16 * 288, I_BR = 8 * 32, I_SQ = 16 * 32, I_PL = 2 * 4, I_RG = 1 * 2;
        constexpr int N_IN = 2 * I_IN, N_BR = 8 * I_BR, N_O = 2 * I_SQ, N_KV = 2 * I_SQ, N_PL = 8 * I_PL, N_RG = 16 * I_RG;
        constexpr int NITEMS = N_IN + N_BR + N_O + N_KV + N_PL + 2 * N_RG;
        for (int it = gw; it < NITEMS; it += NGW) {
            int r = it;
            if (r < N_IN) { const int l = r / I_IN; transpose_item(ap->w_in + (size_t)l * DM * NIN, DM, NIN, Win_t + (size_t)l * NIN * DM, DM, scr, r % I_IN, lane); continue; } r -= N_IN;
            if (r < N_BR) { const int q = r / I_BR; transpose_item(ap->w_branch + (size_t)q * 512 * DM, 512, DM, Wb_t + (size_t)q * 1024 * 1024, 1024, scr, r % I_BR, lane); continue; } r -= N_BR;
            if (r < N_O) { const int l = r / I_SQ; transpose_item(ap->w_out + (size_t)l * DM * DM, DM, DM, Wo_t + (size_t)l * DM * DM, DM, scr, r % I_SQ, lane); continue; } r -= N_O;
            if (r < N_KV) { const int l = r / I_SQ; transpose_item(ap->w_mem_kv + (size_t)l * DM * DM, DM, DM, Wkv_t + (size_t)l * DM * DM, DM, scr, r % I_SQ, lane); continue; } r -= N_KV;
            if (r < N_PL) { const int q = r / I_PL; transpose_item(ap->w_pool + (size_t)q * 128 * 128, 128, 128, Wpool_t + (size_t)q * 128 * 128, 128, scr, r % I_PL, lane); continue; } r -= N_PL;
            if (r < N_RG) { const int q = r / I_RG; transpose_item(ap->w_rg + (size_t)q * 64 * 64, 64, 64, Wrg_t + (size_t)q * 64 * 64, 64, scr, r % I_RG, lane); continue; } r -= N_RG;
            { const int q = r / I_RG; transpose_item(ap->w_ig + (size_t)q * 64 * 64, 64, 64, Wig_t + (size_t)q * 64 * 64, 64, scr, r % I_RG, lane); }
        }
        const float* x = ap->x; const float* mem = ap->mem;
        const size_t gt = (size_t)c * 512 + tid, GT = (size_t)G * 512;
        for (size_t i = gt; i < (size_t)NBATCH * SEQ * DM / 8; i += 4 * GT) {
            f32x4 v0[4], v1[4];
#pragma unroll
            for (int q = 0; q < 4; ++q) { v0[q] = *(const f32x4*)(x + (i + q * GT) * 8); v1[q] = *(const f32x4*)(x + (i + q * GT) * 8 + 4); }
#pragma unroll
            for (int q = 0; q < 4; ++q) { u32x4 o; o.x = cvt_pk_bf16(v0[q][0], v0[q][1]); o.y = cvt_pk_bf16(v0[q][2], v0[q][3]); o.z = cvt_pk_bf16(v1[q][0], v1[q][1]); o.w = cvt_pk_bf16(v1[q][2], v1[q][3]);
                *(u32x4*)(XN + (i + q * GT) * 8) = o; } }
        for (size_t i = gt; i < (size_t)NBATCH * MEMLEN * DM / 8; i += GT) { const f32x4 v0 = *(const f32x4*)(mem + i * 8), v1 = *(const f32x4*)(mem + i * 8 + 4);
            u32x4 o; o.x = pk2(v0[0], v0[1]); o.y = pk2(v0[2], v0[3]); o.z = pk2(v1[0], v1[1]); o.w = pk2(v1[2], v1[3]); *(u32x4*)(MEMB + i * 8) = o; }
    }
    if (gridDim.x == 0x7fffffffu) grid.sync();
    GRID_BAR();

    for (int l = 0; l < NLAYER; ++l) {
        for (int b = 0; b < NBATCH; ++b) {
            {
                __syncthreads();
                ArgsP ap = args_ptr(); unsigned char* ws = ap->ws; const int c = bid_();
                SchedP1 S{(const char*)(ws + WS_XN) + (size_t)b * SEQ * DM * 2, (const char*)(ws + WS_WIN) + (size_t)l * NIN * DM * 2, c};
                EpiP1 E{(bf16_t*)(ws + WS_PROJ), PW};
                pg8::gemm_phase<EpiP1, SchedP1, true>(lds, 2048, 2048, S, E);
            }
            if (l == 0 && b == 0) {
                ArgsP ap = args_ptr(); unsigned char* ws = ap->ws; const int c = bid_();
                __syncthreads();
                SchedKV S{(const char*)(ws + WS_MEMB), (const char*)(ws + WS_WKV), c};
                EpiP1 E{(bf16_t*)(ws + WS_KVM) + (size_t)(c >> 3) * 512 * 1024, 1024};
                pg8::gemm_phase<EpiP1, SchedKV, true>(lds, 2048, 2048, S, E);
            }
            GRID_BAR();
            {
                ArgsP ap = args_ptr(); unsigned char* ws = ap->ws; const int c = bid_();
                const bf16_t* PROJ = (const bf16_t*)(ws + WS_PROJ); bf16_t* Y23 = (bf16_t*)(ws + WS_Y) + (size_t)16384 * 1024;
                float* AGG = (float*)(ws + WS_AGG); float* GAGG = AGG + 256 * 1024;
                unsigned* bar = (unsigned*)ws; unsigned* cnt1 = bar + 3584 + 64 * (l * 2 + b); unsigned* cnt2 = bar + 3584 + 64 * (4 + l * 2 + b);
                __syncthreads();
                lru_stage(lds, ap->conv_w + (size_t)l * 2048, ap->conv_b + l * 512, ap->b_rg + l * 512, ap->b_ig + l * 512, ap->lru_L + l * 512);
                __syncthreads();
                lru_unit<false>(lds, PROJ, Y23, AGG, GAGG, (const bf16_t*)(ws + WS_SMALL + 262144) + (size_t)l * 32768, (const bf16_t*)(ws + WS_SMALL + 262144 + 131072) + (size_t)l * 32768, ws + WS_GSCR + ((size_t)c * 4 + 3) * 131072, c);
                flag_arrive_wt(cnt1);
                __syncthreads();
            }
            {
                __syncthreads();
                ArgsP ap = args_ptr(); unsigned char* ws = ap->ws; const int c = bid_(), G = gridDim.x;
                const bf16_t* PROJ = (const bf16_t*)(ws + WS_PROJ); bf16_t* Y01 = (bf16_t*)(ws + WS_Y);
                for (int u = c; u < 512; u += G) sb_unit(lds, PROJ, Y01, u & 3, tile_of(u));
                __syncthreads();
            }
            {
                ArgsP ap = args_ptr(); unsigned char* ws = ap->ws; const int c = bid_();
                float* AGG = (float*)(ws + WS_AGG); float* GAGG = AGG + 256 * 1024;
                unsigned* bar = (unsigned*)ws; unsigned* cnt1 = bar + 3584 + 64 * (l * 2 + b); unsigned* cnt2 = bar + 3584 + 64 * (4 + l * 2 + b);
                if (c < 16) {
                    flag_wait_nf(cnt1, 256u, bar);
                    const int ch = tid_(); float Pg = 1.f, Hg = 0.f; const float* ab = AGG + (size_t)c * 16 * 1024 + ch;
#pragma unroll
                    for (int i = 0; i < 16; ++i) { const float a = ld_agent(ab + i * 1024), bb = ld_agent(ab + i * 1024 + 512); Hg = a * Hg + bb; Pg *= a; }
                    __hip_atomic_store(GAGG + c * 1024 + ch, Pg, __ATOMIC_RELAXED, __HIP_MEMORY_SCOPE_AGENT); __hip_atomic_store(GAGG + c * 1024 + 512 + ch, Hg, __ATOMIC_RELAXED, __HIP_MEMORY_SCOPE_AGENT);
                    flag_arrive_wt(cnt2);
                }
            }
            {
                __syncthreads();
                ArgsP ap = args_ptr(); unsigned char* ws = ap->ws; const int c = bid_(), G = gridDim.x;
                const bf16_t* PROJ = (const bf16_t*)(ws + WS_PROJ); bf16_t* Y01 = (bf16_t*)(ws + WS_Y);
                const bf16_t* Wpool_t = (const bf16_t*)(ws + WS_SMALL); const float* psc = ap->pool_scale + l * 512;
                int gcur = -1;
                for (int u = c; u < 512; u += G) { const int g = u & 3;
                    if (g != gcur) { __syncthreads(); pool_stage(lds, Wpool_t + (size_t)(l * 4 + g) * 16384); __syncthreads(); gcur = g; }
                    pool_tile(lds, PROJ, Y01, psc, g, tile_of(u)); }
                __syncthreads();
            }
            {
                __syncthreads();
                ArgsP ap = args_ptr(); unsigned char* ws = ap->ws; const int c = bid_(), G = gridDim.x;
                const bf16_t* PROJ = (const bf16_t*)(ws + WS_PROJ); bf16_t* Y23 = (bf16_t*)(ws + WS_Y) + (size_t)16384 * 1024;
                const bf16_t* KVM = (const bf16_t*)(ws + WS_KVM) + (size_t)l * 512 * 1024 + (size_t)b * 256 * 1024;
                int hcur = -1;
                for (int u = c; u < 512; u += G) { const int h = u & 3;
                    if (h != hcur) { __syncthreads(); xa_stage(lds, KVM, h); __syncthreads(); hcur = h; }
                    xa_tile(lds, PROJ, Y23, h, u >> 2); }
            }
            {
                ArgsP ap = args_ptr(); unsigned char* ws = ap->ws; const int c = bid_();
                const bf16_t* PROJ = (const bf16_t*)(ws + WS_PROJ); bf16_t* Y23 = (bf16_t*)(ws + WS_Y) + (size_t)16384 * 1024;
                float* AGG = (float*)(ws + WS_AGG); float* GAGG = AGG + 256 * 1024;
                unsigned* bar = (unsigned*)ws; unsigned* cnt2 = bar + 3584 + 64 * (4 + l * 2 + b);
                __syncthreads();
                flag_wait_nf(cnt2, 16u, bar);
                lru_final(lds, PROJ, Y23, AGG, GAGG, ws + WS_GSCR + ((size_t)c * 4 + 3) * 131072, c);
            }
            {
                __syncthreads();
                ArgsP ap = args_ptr(); unsigned char* ws = ap->ws; const int c = bid_();
                SchedP3G S{(const char*)(ws + WS_XN) + (size_t)b * SEQ * DM * 2, (const char*)(ws + WS_WIN) + ((size_t)l * NIN + 5120) * DM * 2, c};
                EpiP3G E{ws + WS_GSCR + (size_t)c * 4 * 131072};
                pg8::gemm_phase<EpiP3G, SchedP3G, true>(lds, 2048, 2048, S, E);
            }
            GRID_BAR();
            {
                __syncthreads();
                ArgsP ap = args_ptr(); unsigned char* ws = ap->ws; const int c = bid_();
                SchedP3B S2{(const char*)(ws + WS_Y), (const char*)(ws + WS_WB) + (size_t)l * 4 * 1024 * 1024 * 2, c};
                EpiP3B E2{ws + WS_GSCR + (size_t)c * 4 * 131072, (bf16_t*)(ws + WS_GSCR + (size_t)c * 4 * 131072)};
                pg8::gemm_phase<EpiP3B, SchedP3B, true>(lds, 2048, 2048, S2, E2);
            }
            {
                ArgsP ap = args_ptr(); unsigned char* ws = ap->ws; const int c = bid_();
                const int pm = 8 * (c & 7) + ((c >> 3) >> 2);
                unsigned* bar = (unsigned*)ws; unsigned* cntA = bar + 4096 + (((l * 2 + b) * 2 + 0) * 64 + pm) * 16; unsigned* cntB = bar + 4096 + (((l * 2 + b) * 2 + 1) * 64 + pm) * 16;
                flag_arrive_wt(cntA);
                flag_wait(cntA, 4u, bar);
                const float* xres = (l == 0 ? ap->x : (const float*)ap->out) + (size_t)b * SEQ * DM;
                SchedP4 S{(const char*)(ws + WS_GSCR), (const char*)(ws + WS_WO) + (size_t)l * DM * DM * 2, c};
                EpiP4 E{xres, ap->out + (size_t)b * SEQ * DM, (l + 1 < NLAYER) ? (bf16_t*)(ws + WS_XN) + (size_t)b * SEQ * DM : (bf16_t*)nullptr, ap->ln_g + l * DM, ap->ln_b + l * DM,
                        (float*)(ws + WS_AGG + 1536 * 1024), cntB, bar};
                pg8::gemm_phase<EpiP4, SchedP4, true, true>(lds, 512, 2048, S, E);
            }
        }
    }
}

extern "C" void kernel_launch(void* const* d_in, const int* in_sizes, int n_in, void* d_out, int out_size, void* d_ws, size_t ws_size, hipStream_t stream) {
    static int ok = 0;
    if (ok == 0) {
        ok = 1;
        if (n_in != 17 || ws_size < WS_END) { fprintf(stderr, "kernel_launch: unexpected inputs (n_in %d, ws %zu)\n", n_in, ws_size); ok = -1; }
        if (hipFuncSetAttribute((const void*)mk_fwd, hipFuncAttributeMaxDynamicSharedMemorySize, LDS_BYTES) != hipSuccess) { fprintf(stderr, "kernel_launch: hipFuncSetAttribute failed\n"); ok = -1; }
        (void)hipGetLastError();
    }
    if (ok < 0) return;
    Args a{};
    a.x = (const float*)d_in[0]; a.mem = (const float*)d_in[1]; a.w_in = (const float*)d_in[2]; a.w_pool = (const float*)d_in[3]; a.pool_scale = (const float*)d_in[4];
    a.conv_w = (const float*)d_in[5]; a.conv_b = (const float*)d_in[6]; a.w_rg = (const float*)d_in[7]; a.b_rg = (const float*)d_in[8]; a.w_ig = (const float*)d_in[9];
    a.b_ig = (const float*)d_in[10]; a.lru_L = (const float*)d_in[11]; a.w_mem_kv = (const float*)d_in[12]; a.w_branch = (const float*)d_in[13]; a.w_out = (const float*)d_in[14];
    a.ln_g = (const float*)d_in[15]; a.ln_b = (const float*)d_in[16]; a.out = (float*)d_out; a.ws = (unsigned char*)d_ws;
    (void)hipMemsetAsync(d_ws, 0, 49152, stream);
    void* args[] = {&a};
    hipError_t e = hipLaunchCooperativeKernel((const void*)mk_fwd, dim3(256), dim3(512), args, LDS_BYTES, stream);
    if (e != hipSuccess) fprintf(stderr, "kernel_launch: cooperative launch failed: %s\n", hipGetErrorString(e));
}
```

```cpp
#include <hip/hip_runtime.h>
#include <hip/hip_cooperative_groups.h>
#include <cstdio>
#include <cstdint>
namespace cg = cooperative_groups;

#define LAS __attribute__((address_space(3)))
typedef unsigned short bf16_t;
typedef short bf16x8 __attribute__((ext_vector_type(8)));
typedef float f32x4 __attribute__((ext_vector_type(4)));
typedef unsigned u32x4 __attribute__((ext_vector_type(4)));
typedef unsigned u32x2 __attribute__((ext_vector_type(2)));

constexpr int DM = 1024, SEQ = 16384, NBATCH = 2, NIN = 9216, PW = 5120, MEMLEN = 256, NLAYER = 2;
constexpr float DN_ALPHA = 1.41421356237f, LN_EPS = 1e-5f;
constexpr size_t MiB = 1024 * 1024;
constexpr size_t WS_SMALL = 1 * MiB;
constexpr size_t WS_MEMB = 2 * MiB;
constexpr size_t WS_KVM = 3 * MiB;
constexpr size_t WS_AGG = 5 * MiB;
constexpr size_t WS_WIN = 8 * MiB;
constexpr size_t WS_WB = 44 * MiB;
constexpr size_t WS_WO = 60 * MiB;
constexpr size_t WS_WKV = 64 * MiB;
constexpr size_t WS_XN = 72 * MiB;
constexpr size_t WS_PROJ = 136 * MiB;
constexpr size_t WS_Y = 296 * MiB;
constexpr size_t WS_GSCR = 360 * MiB;
constexpr size_t WS_END = 488 * MiB;
constexpr int LDS_BYTES = 147456;
constexpr int LDS_BARW = 147456 - 64;

__device__ __forceinline__ unsigned cvt_pk_bf16(float lo, float hi) { unsigned r; asm volatile("v_cvt_pk_bf16_f32 %0, %1, %2" : "=v"(r) : "v"(lo), "v"(hi)); return r; }
__device__ __forceinline__ float bf_lo(unsigned u) { return __uint_as_float(u << 16); }
__device__ __forceinline__ float bf_hi(unsigned u) { return __uint_as_float(u & 0xffff0000u); }
__device__ __forceinline__ float bf1(bf16_t u) { return __uint_as_float(((unsigned)u) << 16); }
__device__ __forceinline__ float rcp_(float x) { return __builtin_amdgcn_rcpf(x); }
__device__ __forceinline__ float sigmoidf_(float x) { return rcp_(1.0f + __expf(-x)); }
__device__ __forceinline__ float siluf_(float x) { return x * rcp_(1.0f + __expf(-x)); }
__device__ __forceinline__ int tid_() { int t = threadIdx.x; asm volatile("" : "+v"(t)); return t; }
__device__ __forceinline__ int bid_() { int t = blockIdx.x; asm volatile("" : "+s"(t)); return t; }
__device__ __forceinline__ float bperm(int addr4, float v) { return __int_as_float(__builtin_amdgcn_ds_bpermute(addr4, __float_as_int(v))); }
typedef short s16x4 __attribute__((ext_vector_type(4)));
__device__ __forceinline__ u32x2 lds_tr16(const LAS bf16_t* p) { return __builtin_bit_cast(u32x2, __builtin_amdgcn_ds_read_tr16_b64_v4i16((LAS s16x4*)p)); }
__device__ __forceinline__ __amdgpu_buffer_rsrc_t mk_rsrc(const void* p) { return __builtin_amdgcn_make_buffer_rsrc((void*)p, 0, 0x7fffffff, 0x00020000); }
__device__ __forceinline__ void st_wt16(__amdgpu_buffer_rsrc_t rs, int byte_off, u32x4 v) { __builtin_amdgcn_raw_buffer_store_b128(v, rs, byte_off, 0, 16); }
__device__ __forceinline__ void st_wt8(__amdgpu_buffer_rsrc_t rs, int byte_off, u32x2 v) { __builtin_amdgcn_raw_buffer_store_b64(v, rs, byte_off, 0, 16); }
__device__ __forceinline__ int tile_of(int u) { return ((((u & 7) >> 2) * 2 + (u >> 8)) * 32) + ((u & 255) >> 3); }
__device__ __forceinline__ void store_row_tiles(const __amdgpu_buffer_rsrc_t rs, const int base_byte, const u32x2 (&r)[8], const int lane, const int quad) {
    const bool odd = (quad & 1) != 0; const int pa = (lane ^ 16) << 2;
#pragma unroll
    for (int tp = 0; tp < 4; ++tp) {
        const u32x2 mine0 = r[2 * tp], mine1 = r[2 * tp + 1];
        const u32x2 snd = odd ? mine0 : mine1; u32x2 rcv;
        rcv.x = (unsigned)__builtin_amdgcn_ds_bpermute(pa, (int)snd.x); rcv.y = (unsigned)__builtin_amdgcn_ds_bpermute(pa, (int)snd.y);
        const u32x4 o = odd ? (u32x4){rcv.x, rcv.y, mine1.x, mine1.y} : (u32x4){mine0.x, mine0.y, rcv.x, rcv.y};
        const int d = odd ? (2 * tp + 1) * 16 + (quad - 1) * 4 : (2 * tp) * 16 + quad * 4;
        __builtin_amdgcn_raw_buffer_store_b128(o, rs, base_byte + d * 2, 0, 0); }
}
#define LDS_WAIT() asm volatile("s_waitcnt lgkmcnt(0)" ::: "memory")

__device__ __forceinline__ void flag_arrive(unsigned* cnt);
__device__ __forceinline__ void flag_arrive_wt(unsigned* cnt);
__device__ __forceinline__ void flag_wait_nf(unsigned* cnt, unsigned target, unsigned* bar);
__device__ __forceinline__ void flag_wait(unsigned* cnt, unsigned target, unsigned* bar);
namespace pg8 {
constexpr int BM = 256, BK = 64, HALF = 128, HTB = HALF * BK * 2;
__device__ __forceinline__ int lds_byte(int r, int c) { const int st = (r >> 4) * 2 + (c >> 5), rr = r & 15, cc = c & 31, ob = rr * 64 + cc * 2; return st * 1024 + (ob ^ (((ob >> 9) & 1) << 5)); }
__device__ __forceinline__ void stage_rc(int b, int& R, int& C) { const int st = b / 1024, sb = b % 1024, swz = sb ^ (((sb >> 9) & 1) << 5); R = (st >> 1) * 16 + swz / 64; C = (st & 1) * 32 + (swz % 64) / 2; }
__device__ __forceinline__ int perm32(int rho) { const int n = rho >> 4, i = rho & 15; return 8 * (i >> 2) + 4 * n + (i & 3); }

struct UD { const char* A; const char* B; int nt, kind, pm, pn, aux; };

template <class Epi, class Sched, bool ALIGN_EPI, bool AFTER_DRAIN = false>
__device__ __forceinline__ void gemm_phase(LAS unsigned char* lds, const int lda2, const int ldb2, const Sched& S, const Epi& E) {
    const int tid = tid_(), wid = __builtin_amdgcn_readfirstlane(tid >> 6), lane = tid & 63, wr = wid >> 2, wc = wid & 3, fr = lane & 15, fq = lane >> 4;
    unsigned voffA[2], voffB[2];
#pragma unroll
    for (int i = 0; i < 2; ++i) { int R, C; stage_rc(tid * 16 + i * 8192, R, C); const int Rb = Epi::PERM ? ((R & ~31) + perm32(R & 31)) : R;
        voffA[i] = (unsigned)(R * lda2 + C * 2); voffB[i] = (unsigned)(Rb * ldb2 + C * 2); }
    const size_t kstep = (size_t)(BK * 2);
    const size_t hA = (size_t)HALF * lda2, hB = (size_t)HALF * ldb2;
    const unsigned ldsw = (unsigned)wid * 1024u;
    const int aoff = lds_byte(wr * 64 + fr, fq * 8), boff = lds_byte(wc * 32 + fr, fq * 8);
#define PG8_SA(b, h) (((b) * 2 + (h)) * HTB)
#define PG8_SB(b, h) ((4 + (b) * 2 + (h)) * HTB)
#define PG8_STAGE(bufoff, gbase, voff) do { _Pragma("unroll") for (int _i = 0; _i < 2; ++_i) \
        __builtin_amdgcn_global_load_lds((const unsigned*)((const char*)(gbase) + (voff)[_i]), (LAS unsigned*)(lds + (bufoff) + ldsw + _i * 8192), 16, 0, 0); } while (0)
#define PG8_LDA(dst, b, h) do { _Pragma("unroll") for (int m = 0; m < 4; ++m) _Pragma("unroll") for (int k = 0; k < 2; ++k) dst[m][k] = *(const LAS bf16x8*)(lds + PG8_SA(b, h) + aoff + m * 2048 + k * 1024); } while (0)
#define PG8_LDB(dst, b, h) do { _Pragma("unroll") for (int n = 0; n < 2; ++n) _Pragma("unroll") for (int k = 0; k < 2; ++k) dst[n][k] = *(const LAS bf16x8*)(lds + PG8_SB(b, h) + boff + n * 2048 + k * 1024); } while (0)
#define PG8_MMA(ai, bj, At, Bt) do { __builtin_amdgcn_s_setprio(1); _Pragma("unroll") for (int m = 0; m < 4; ++m) _Pragma("unroll") for (int n = 0; n < 2; ++n) _Pragma("unroll") for (int k = 0; k < 2; ++k) \
        acc[ai][bj][m][n] = __builtin_amdgcn_mfma_f32_16x16x32_bf16(Bt[n][k], At[m][k], acc[ai][bj][m][n], 0, 0, 0); __builtin_amdgcn_s_setprio(0); } while (0)
#define PG8_WAIT_V(n) asm volatile("s_waitcnt vmcnt(" #n ")" ::: "memory")
#define PG8_WAIT_L(n) asm volatile("s_waitcnt lgkmcnt(" #n ")" ::: "memory")
#define PG8_BAR __builtin_amdgcn_s_barrier()
#define PG8_SCHED __builtin_amdgcn_sched_barrier(0)
    UD cur, nxt; int ui = 0;
    if (!S.next(0, cur)) return;
    f32x4 acc[2][2][4][2];
#pragma unroll
    for (int a = 0; a < 2; ++a)
#pragma unroll
        for (int b = 0; b < 2; ++b)
#pragma unroll
            for (int m = 0; m < 4; ++m)
#pragma unroll
                for (int n = 0; n < 2; ++n) acc[a][b][m][n] = (f32x4){0.f, 0.f, 0.f, 0.f};
    bf16x8 At[4][2], B0[2][2], B1[2][2];
    const char* cA = cur.A; const char* cB = cur.B;
    PG8_STAGE(PG8_SB(0, 0), cB, voffB); PG8_STAGE(PG8_SB(0, 1), cB + hB, voffB); PG8_STAGE(PG8_SA(0, 0), cA, voffA); PG8_STAGE(PG8_SA(0, 1), cA + hA, voffA);
    if (wr == 1) PG8_BAR;
    PG8_WAIT_V(2); PG8_BAR;
    PG8_STAGE(PG8_SB(1, 0), cB + kstep, voffB); PG8_STAGE(PG8_SA(1, 0), cA + kstep, voffA); PG8_STAGE(PG8_SB(1, 1), cB + hB + kstep, voffB);
    PG8_WAIT_V(6); PG8_BAR;
    for (;;) {
        const bool has_next = S.next(ui + 1, nxt);
        const char* nA = has_next ? nxt.A : cA; const char* nB = has_next ? nxt.B : cB;
        const int nt = cur.nt;
        for (int t = 0; t < nt; t += 2) {
            const bool last = (t == nt - 2);
            const char* a1 = cA + (size_t)(t + 1) * kstep;
            const char* a2 = last ? nA : cA + (size_t)(t + 2) * kstep; const char* b2 = last ? nB : cB + (size_t)(t + 2) * kstep;
            const char* a3 = a2 + kstep; const char* b3 = b2 + kstep;
            PG8_LDB(B0, 0, 0); PG8_LDB(B1, 0, 1); PG8_SCHED; PG8_LDA(At, 0, 0); PG8_STAGE(PG8_SA(1, 1), a1 + hA, voffA);
            PG8_WAIT_V(8); PG8_WAIT_L(0); PG8_BAR; PG8_MMA(0, 0, At, B0); PG8_MMA(0, 1, At, B1); PG8_BAR; PG8_SCHED;
            PG8_LDA(At, 0, 1); PG8_STAGE(PG8_SB(0, 0), b2, voffB); PG8_STAGE(PG8_SB(0, 1), b2 + hB, voffB); PG8_STAGE(PG8_SA(0, 0), a2, voffA);
            PG8_WAIT_V(8); PG8_WAIT_L(0); PG8_BAR; PG8_MMA(1, 0, At, B0); PG8_MMA(1, 1, At, B1); PG8_BAR; PG8_SCHED;
            PG8_LDB(B0, 1, 0); PG8_LDB(B1, 1, 1); PG8_SCHED; PG8_LDA(At, 1, 0); PG8_STAGE(PG8_SA(0, 1), a2 + hA, voffA);
            PG8_WAIT_V(8); PG8_WAIT_L(0); PG8_BAR; PG8_MMA(0, 0, At, B0); PG8_MMA(0, 1, At, B1); PG8_BAR; PG8_SCHED;
            PG8_LDA(At, 1, 1); PG8_STAGE(PG8_SB(1, 0), b3, voffB); PG8_STAGE(PG8_SB(1, 1), b3 + hB, voffB); PG8_STAGE(PG8_SA(1, 0), a3, voffA);
            PG8_WAIT_V(8); PG8_WAIT_L(0); PG8_BAR; PG8_MMA(1, 0, At, B0); PG8_MMA(1, 1, At, B1); PG8_BAR; PG8_SCHED;
        }
        if constexpr (ALIGN_EPI) { if (wr == 0) PG8_BAR; }
        bool zero = false;
        if (!AFTER_DRAIN || has_next) zero = E(acc, cur, wr, wc, fr, fq);
        if (!has_next) break;
        if (zero) {
#pragma unroll
            for (int a = 0; a < 2; ++a)
#pragma unroll
                for (int b = 0; b < 2; ++b)
#pragma unroll
                    for (int m = 0; m < 4; ++m)
#pragma unroll
                        for (int n = 0; n < 2; ++n) acc[a][b][m][n] = (f32x4){0.f, 0.f, 0.f, 0.f};
        }
        cur = nxt; cA = nA; cB = nB; ++ui;
        if constexpr (ALIGN_EPI) { if (wr == 1) PG8_BAR; }
    }
    PG8_WAIT_V(0);
    if constexpr (!ALIGN_EPI) { if (wr == 0) PG8_BAR; }
    PG8_BAR;
    if constexpr (AFTER_DRAIN) E.fused(acc, cur, wr, wc, fr, fq, lds);
#undef PG8_SA
#undef PG8_SB
#undef PG8_STAGE
#undef PG8_LDA
#undef PG8_LDB
#undef PG8_MMA
#undef PG8_WAIT_V
#undef PG8_WAIT_L
#undef PG8_BAR
#undef PG8_SCHED
}
}
using pg8::UD;

struct EpiP1 {
    static constexpr bool PERM = true;
    bf16_t* O; int ldc;
    __device__ __forceinline__ bool operator()(const f32x4 (&acc)[2][2][4][2], const UD& u, int wr, int wc, int fr, int fq) const {
        const int row0 = u.pm * 256 + wr * 64 + fr, col0 = u.pn * 256 + wc * 32 + 8 * fq;
        const __amdgpu_buffer_rsrc_t rs = __builtin_amdgcn_make_buffer_rsrc((void*)O, 0, 0x7fffffff, 0x00020000);
        const int voff = (row0 * ldc + col0) * 2;
#pragma unroll
        for (int ai = 0; ai < 2; ++ai)
#pragma unroll
            for (int m = 0; m < 4; ++m) {
#pragma unroll
                for (int bj = 0; bj < 2; ++bj) { const f32x4 v0 = acc[ai][bj][m][0], v1 = acc[ai][bj][m][1]; u32x4 w;
                    w.x = cvt_pk_bf16(v0[0], v0[1]); w.y = cvt_pk_bf16(v0[2], v0[3]); w.z = cvt_pk_bf16(v1[0], v1[1]); w.w = cvt_pk_bf16(v1[2], v1[3]);
                    __builtin_amdgcn_raw_buffer_store_b128(w, rs, voff, ((ai * 128 + m * 16) * ldc + bj * 128) * 2, 16); } }
        return true;
    }
};
struct SchedP1 {
    const char* A; const char* W; int c;
    __device__ __forceinline__ bool next(int i, UD& u) const {
        if (i >= 5) return false;
        const int xcd = c & 7, j = c >> 3, idx = i * 32 + j, pn = idx >> 3, pm = xcd * 8 + (idx & 7);
        u.A = A + (size_t)pm * 256 * 2048; u.B = W + (size_t)pn * 256 * 2048; u.nt = 16; u.kind = 0; u.pm = pm; u.pn = pn; u.aux = 0; return true;
    }
};
struct SchedKV {
    const char* memb; const char* wkv; int c;
    __device__ __forceinline__ bool next(int i, UD& u) const {
        if (i >= 1 || c >= 16) return false;
        const int lay = c >> 3, pm = (c & 7) >> 2, pn = c & 3;
        u.A = memb + (size_t)pm * 256 * 2048; u.B = wkv + (size_t)lay * 2 * MiB + (size_t)pn * 256 * 2048; u.nt = 16; u.kind = 1; u.pm = pm; u.pn = pn; u.aux = lay; return true;
    }
};
struct EpiP3G {
    static constexpr bool PERM = true;
    unsigned char* gs;
    __device__ __forceinline__ bool operator()(const f32x4 (&acc)[2][2][4][2], const UD& u, int wr, int wc, int fr, int fq) const {
        unsigned char* t = gs + (size_t)u.aux * 131072; const unsigned lo16 = (unsigned)tid_() * 16u;
#pragma unroll
        for (int ai = 0; ai < 2; ++ai)
#pragma unroll
            for (int bj = 0; bj < 2; ++bj)
#pragma unroll
                for (int m = 0; m < 4; ++m) { const int ci = (ai * 2 + bj) * 4 + m; float g[8];
#pragma unroll
                    for (int e = 0; e < 8; ++e) g[e] = fminf(1.0f + __expf(-acc[ai][bj][m][e >> 2][e & 3]), 1e9f);
                    u32x4 w; w.x = cvt_pk_bf16(g[0], g[1]); w.y = cvt_pk_bf16(g[2], g[3]); w.z = cvt_pk_bf16(g[4], g[5]); w.w = cvt_pk_bf16(g[6], g[7]);
                    *(u32x4*)(t + ci * 8192 + lo16) = w; }
        return true;
    }
};
struct SchedP3G {
    const char* xn; const char* wg; int c;
    __device__ __forceinline__ bool next(int i, UD& u) const {
        if (i >= 4) return false;
        const int pm = 8 * (c & 7) + ((c >> 3) >> 2), pn = (c >> 3) & 3; u.pm = pm; u.pn = pn;
        u.A = xn + (size_t)pm * 256 * 2048; u.B = wg + (size_t)(i * 1024 + pn * 256) * 2048; u.nt = 16; u.kind = 2; u.aux = i; return true;
    }
};
struct EpiP3B {
    static constexpr bool PERM = true;
    unsigned char* gs; bf16_t* merged;
    __device__ __forceinline__ bool operator()(f32x4 (&acc)[2][2][4][2], const UD& u, int wr, int wc, int fr, int fq) const {
        const int n = u.aux; const bool fin = (n == 3);
        const __amdgpu_buffer_rsrc_t rs = __builtin_amdgcn_make_buffer_rsrc((void*)gs, 0, 0x7fffffff, 0x00020000);
        const int s0 = n * 131072, s1 = (fin ? 3 : n + 1) * 131072; const int lo16 = (int)tid_() * 16;
#pragma unroll
        for (int ai = 0; ai < 2; ++ai)
#pragma unroll
            for (int bj = 0; bj < 2; ++bj)
#pragma unroll
                for (int m = 0; m < 4; ++m) { const int ci = (ai * 2 + bj) * 4 + m;
                    const u32x4 ga = __builtin_amdgcn_raw_buffer_load_b128(rs, lo16, s0 + ci * 8192, 0);
                    u32x4 gb = __builtin_amdgcn_raw_buffer_load_b128(rs, lo16, s1 + ci * 8192, 0);
                    if (fin) gb = (u32x4){0x3f803f80u, 0x3f803f80u, 0x3f803f80u, 0x3f803f80u};
                    f32x4 v0 = acc[ai][bj][m][0], v1 = acc[ai][bj][m][1];
                    v0[0] *= bf_lo(gb.x) * rcp_(bf_lo(ga.x)); v0[1] *= bf_hi(gb.x) * rcp_(bf_hi(ga.x));
                    v0[2] *= bf_lo(gb.y) * rcp_(bf_lo(ga.y)); v0[3] *= bf_hi(gb.y) * rcp_(bf_hi(ga.y));
                    v1[0] *= bf_lo(gb.z) * rcp_(bf_lo(ga.z)); v1[1] *= bf_hi(gb.z) * rcp_(bf_hi(ga.z));
                    v1[2] *= bf_lo(gb.w) * rcp_(bf_lo(ga.w)); v1[3] *= bf_hi(gb.w) * rcp_(bf_hi(ga.w));
                    acc[ai][bj][m][0] = v0; acc[ai][bj][m][1] = v1; }
        if (!fin) return false;
        const int row0 = wr * 64 + fr, col0 = wc * 32 + 8 * fq;
#pragma unroll
        for (int ai = 0; ai < 2; ++ai)
#pragma unroll
            for (int m = 0; m < 4; ++m) {
#pragma unroll
                for (int bj = 0; bj < 2; ++bj) { const f32x4 v0 = acc[ai][bj][m][0], v1 = acc[ai][bj][m][1]; u32x4 w;
                    w.x = cvt_pk_bf16(v0[0], v0[1]); w.y = cvt_pk_bf16(v0[2], v0[3]); w.z = cvt_pk_bf16(v1[0], v1[1]); w.w = cvt_pk_bf16(v1[2], v1[3]);
                    __builtin_amdgcn_raw_buffer_store_b128(w, rs, (row0 * 256 + col0) * 2, ((ai * 128 + m * 16) * 256 + bj * 128) * 2, 16); } }
        return true;
    }
};
struct SchedP3B {
    const char* y; const char* wb; int c;
    __device__ __forceinline__ bool next(int i, UD& u) const {
        if (i >= 4) return false;
        const int pm = 8 * (c & 7) + ((c >> 3) >> 2), pn = (c >> 3) & 3; u.pm = pm; u.pn = pn;
        u.A = y + (size_t)(i >> 1) * 32 * MiB + (size_t)pm * 256 * 2048 + (size_t)(i & 1) * 1024; u.B = wb + (size_t)i * 2 * MiB + (size_t)pn * 256 * 2048; u.nt = 8; u.kind = 3; u.aux = i; return true;
    }
};
struct EpiP4 {
    static constexpr bool PERM = false;
    const float* xres; float* out; bf16_t* xn; const float* gam; const float* bet; float* stats; unsigned* cnt; unsigned* bar;
    __device__ __forceinline__ bool operator()(const f32x4 (&acc)[2][2][4][2], const UD& u, int wr, int wc, int fr, int fq) const { return false; }
    __device__ __forceinline__ void fused(f32x4 (&acc)[2][2][4][2], const UD& u, int wr, int wc, int fr, int fq, LAS unsigned char* lds) const {
        const int tid = tid_(), lane = tid & 63;
        LAS float* PS = (LAS float*)lds;
        LAS float* RS = (LAS float*)(lds + 8192);
        const int row0 = u.pm * 256 + wr * 64 + fr, col0 = u.pn * 256 + wc * 32 + 4 * fq;
#pragma unroll
        for (int ai = 0; ai < 2; ++ai)
#pragma unroll
            for (int m = 0; m < 4; ++m) { const unsigned off = (unsigned)((row0 + ai * 128 + m * 16) * DM + col0); float sm = 0.f, sq = 0.f;
#pragma unroll
                for (int bj = 0; bj < 2; ++bj)
#pragma unroll
                    for (int n = 0; n < 2; ++n) { const f32x4 xv = *(const f32x4*)(xres + (off + (unsigned)(bj * 128 + n * 16)));
                        const f32x4 v = xv * DN_ALPHA + acc[ai][bj][m][n]; acc[ai][bj][m][n] = v;
                        sm += (v[0] + v[1]) + (v[2] + v[3]); sq += (v[0] * v[0] + v[1] * v[1]) + (v[2] * v[2] + v[3] * v[3]); }
                sm += bperm((lane ^ 16) << 2, sm); sm += bperm((lane ^ 32) << 2, sm); sq += bperm((lane ^ 16) << 2, sq); sq += bperm((lane ^ 32) << 2, sq);
                if (fq == 0) { const int rl = ai * 128 + wr * 64 + m * 16 + fr; PS[(rl * 4 + wc) * 2] = sm; PS[(rl * 4 + wc) * 2 + 1] = sq; }
                if (m & 1) asm volatile("" ::: "memory"); }
        __syncthreads();
        if (tid < 256) { const f32x4 p0 = *(const LAS f32x4*)(PS + tid * 8), p1 = *(const LAS f32x4*)(PS + tid * 8 + 4);
            float* st = stats + ((size_t)(u.pm * 256 + tid) * 4 + u.pn) * 2; const float s_ = (p0[0] + p0[2]) + (p1[0] + p1[2]), q_ = (p0[1] + p0[3]) + (p1[1] + p1[3]);
            __hip_atomic_store((unsigned long long*)st, ((unsigned long long)__float_as_uint(q_) << 32) | __float_as_uint(s_), __ATOMIC_RELAXED, __HIP_MEMORY_SCOPE_AGENT); }
        flag_arrive_wt(cnt);
        flag_wait_nf(cnt, 4u, bar);
        if (tid < 256) { const unsigned long long* st = (const unsigned long long*)(stats + (size_t)(u.pm * 256 + tid) * 8);
            float ssum = 0.f, qsum = 0.f;
#pragma unroll
            for (int k = 0; k < 4; ++k) { const unsigned long long w_ = __hip_atomic_load(st + k, __ATOMIC_RELAXED, __HIP_MEMORY_SCOPE_AGENT); ssum += __uint_as_float((unsigned)w_); qsum += __uint_as_float((unsigned)(w_ >> 32)); }
            const float mean = ssum * (1.0f / DM); const float var = qsum * (1.0f / DM) - mean * mean;
            RS[tid * 2] = mean; RS[tid * 2 + 1] = 1.0f / sqrtf(fmaxf(var, 0.f) + LN_EPS); }
        __syncthreads();
#pragma unroll
        for (int bj = 0; bj < 2; ++bj)
#pragma unroll
            for (int n = 0; n < 2; ++n) { const int cc = col0 + bj * 128 + n * 16; const f32x4 gv = *(const f32x4*)(gam + cc), bv = *(const f32x4*)(bet + cc);
#pragma unroll
                for (int ai = 0; ai < 2; ++ai)
#pragma unroll
                    for (int m = 0; m < 4; ++m) { const int rl = ai * 128 + wr * 64 + m * 16 + fr; const float mean = RS[rl * 2], rstd = RS[rl * 2 + 1];
                        const unsigned off = (unsigned)((u.pm * 256 + rl) * DM + cc);
                        const f32x4 y = (acc[ai][bj][m][n] - mean) * rstd * gv + bv; st_wt16(mk_rsrc(out), (int)(off * 4u), __builtin_bit_cast(u32x4, y));
                        if (xn) { u32x2 pk; pk.x = cvt_pk_bf16(y[0], y[1]); pk.y = cvt_pk_bf16(y[2], y[3]); st_wt8(mk_rsrc(xn), (int)(off * 2u), pk); } } }
    }
};
struct SchedP4 {
    const char* gscr; const char* wo; int c;
    __device__ __forceinline__ bool next(int i, UD& u) const {
        if (i >= 4) return false;
        const int pm = 8 * (c & 7) + ((c >> 3) >> 2), pn = (c >> 3) & 3; u.pm = pm; u.pn = pn;
        const int owner = (pm >> 3) + 8 * (((pm & 7) << 2) + i);
        u.A = gscr + (size_t)owner * 4 * 131072; u.B = wo + (size_t)pn * 256 * 2048 + (size_t)i * 512; u.nt = 4; u.kind = 4; u.aux = i; return true;
    }
};

__device__ __forceinline__ unsigned f2bf(float f) { unsigned u = __builtin_bit_cast(unsigned, f); return (u + 0x7fffu + ((u >> 16) & 1u)) >> 16; }
__device__ __forceinline__ unsigned pk2(float lo, float hi) { return f2bf(lo) | (f2bf(hi) << 16); }
__device__ __forceinline__ void transpose_item(const float* W, int K, int N, bf16_t* WT, int pitch, LAS float* scr, int item, int lane) {
    const int nblk = N / 32, kb = item / nblk, nb = item % nblk, k0 = 64 * kb, n0 = 32 * nb;
    f32x4 tv[8]; const int r8 = lane >> 3, q4 = (lane & 7) * 4;
#pragma unroll
    for (int i = 0; i < 8; ++i) tv[i] = *(const f32x4*)(W + (size_t)(k0 + 8 * i + r8) * N + n0 + q4);
#pragma unroll
    for (int i = 0; i < 8; ++i) { LAS float* d = scr + (8 * i + r8) * 33 + q4; d[0] = tv[i][0]; d[1] = tv[i][1]; d[2] = tv[i][2]; d[3] = tv[i][3]; }
    LDS_WAIT();
    const int c = lane & 7;
#pragma unroll
    for (int j = 0; j < 4; ++j) { const int n = (lane >> 3) + 8 * j; const LAS float* s = scr + (8 * c) * 33 + n;
        u32x4 o; o.x = pk2(s[0 * 33], s[1 * 33]); o.y = pk2(s[2 * 33], s[3 * 33]); o.z = pk2(s[4 * 33], s[5 * 33]); o.w = pk2(s[6 * 33], s[7 * 33]);
        *(u32x4*)(WT + (size_t)(n0 + n) * pitch + k0 + 8 * c) = o; }
    LDS_WAIT();
}

struct Args {
    const float* x; const float* mem; const float* w_in; const float* w_pool; const float* pool_scale; const float* conv_w; const float* conv_b;
    const float* w_rg; const float* b_rg; const float* w_ig; const float* b_ig; const float* lru_L; const float* w_mem_kv; const float* w_branch;
    const float* w_out; const float* ln_g; const float* ln_b; float* out; unsigned char* ws;
};

__device__ __forceinline__ void sb_unit(LAS unsigned char* lds, const bf16_t* __restrict__ P, bf16_t* __restrict__ Y01, const int h, const int i) {
    const int tid = tid_(), lane = tid & 63, w = __builtin_amdgcn_readfirstlane(tid >> 6), ql = lane & 15, quad = lane >> 4;
    LAS bf16_t* Ks = (LAS bf16_t*)lds;
    LAS bf16_t* Vs = Ks + 128 * 136;
    const LAS bf16_t* vtr = Vs + (quad * 4 + (ql >> 2)) * 144 + 4 * (ql & 3);
    const int qloc = w * 16 + ql; const size_t qrow = (size_t)i * 128 + qloc;
    const float scale2 = 0.08838834764831845f * 1.4426950408889634f;
    bf16x8 qf[4];
#pragma unroll
    for (int ks = 0; ks < 4; ++ks) qf[ks] = *(const bf16x8*)(P + qrow * PW + h * 128 + ks * 32 + quad * 8);
    f32x4 o[8]; u32x2 gq[8];
#pragma unroll
    for (int d = 0; d < 8; ++d) { o[d] = (f32x4){0.f, 0.f, 0.f, 0.f}; gq[d] = *(const u32x2*)(P + qrow * PW + 1536 + h * 128 + d * 16 + quad * 4); }
    float later = 0.f; int wdone = 0;
    u32x4 kreg[4], vreg[4];
#define SB_LOAD(JJ) do { _Pragma("unroll") for (int q_ = 0; q_ < 4; ++q_) { const int c_ = tid + q_ * 512, r_ = c_ >> 4, cc_ = c_ & 15; \
            const bf16_t* kp_ = P + ((size_t)(JJ) * 128 + r_) * PW + 512 + h * 128 + cc_ * 8; kreg[q_] = *(const u32x4*)kp_; vreg[q_] = *(const u32x4*)(kp_ + 512); } } while (0)
    SB_LOAD(i);
    __syncthreads();
    for (int j = i; ; --j) {
#pragma unroll
        for (int q = 0; q < 4; ++q) { const int c = tid + q * 512, r = c >> 4, cc = c & 15; *(LAS u32x4*)(Ks + r * 136 + cc * 8) = kreg[q]; *(LAS u32x4*)(Vs + r * 144 + cc * 8) = vreg[q]; }
        __syncthreads();
        if (j > 0) SB_LOAD(j - 1);
        if (!wdone) {
            const bool diag = (j == i);
            float R = later;
#pragma unroll
            for (int p = 3; p >= 0; --p) {
                if (!wdone && !(diag && 2 * p > w)) {
                    f32x4 s0 = (f32x4){0.f, 0.f, 0.f, 0.f}, s1 = (f32x4){0.f, 0.f, 0.f, 0.f};
#pragma unroll
                    for (int ks = 0; ks < 4; ++ks) {
                        const bf16x8 a0 = *(const LAS bf16x8*)(Ks + ((2 * p) * 16 + ql) * 136 + ks * 32 + quad * 8);
                        const bf16x8 a1 = *(const LAS bf16x8*)(Ks + ((2 * p + 1) * 16 + ql) * 136 + ks * 32 + quad * 8);
                        s0 = __builtin_amdgcn_mfma_f32_16x16x32_bf16(a0, qf[ks], s0, 0, 0, 0); s1 = __builtin_amdgcn_mfma_f32_16x16x32_bf16(a1, qf[ks], s1, 0, 0, 0); }
                    unsigned pw[4];
#pragma unroll
                    for (int hh = 1; hh >= 0; --hh) { const int kt = 2 * p + hh; const f32x4 sv = hh ? s1 : s0;
                        float l1[4], ls[4]; bool vd[4];
#pragma unroll
                        for (int e = 0; e < 4; ++e) { const float z = sv[e] * scale2; const float t = __builtin_amdgcn_logf(1.0f + __builtin_amdgcn_exp2f(-fabsf(z)));
                            vd[e] = !diag || (kt * 16 + quad * 4 + e < qloc);
                            const float nsp = -(fmaxf(z, 0.f) + t);
                            l1[e] = vd[e] ? nsp : 0.f; ls[e] = z + nsp; }
                        const float sl = (l1[0] + l1[1]) + (l1[2] + l1[3]);
                        const float x1 = bperm((lane ^ 16) << 2, sl); const float s1 = sl + x1;
                        const float y = bperm((lane ^ 32) << 2, s1);
                        const float gt = (((quad & 1) == 0) ? x1 : 0.f) + (((quad & 2) == 0) ? y : 0.f);
                        const float T = s1 + y;
                        const float w3 = R + gt, w2 = w3 + l1[3], w1 = w2 + l1[2], w0 = w1 + l1[1];
                        const float p0 = vd[0] ? __builtin_amdgcn_exp2f(ls[0] + w0) : 0.f, p1 = vd[1] ? __builtin_amdgcn_exp2f(ls[1] + w1) : 0.f;
                        const float p2 = vd[2] ? __builtin_amdgcn_exp2f(ls[2] + w2) : 0.f, p3 = vd[3] ? __builtin_amdgcn_exp2f(ls[3] + w3) : 0.f;
                        pw[hh * 2] = cvt_pk_bf16(p0, p1); pw[hh * 2 + 1] = cvt_pk_bf16(p2, p3);
                        R += T; }
                    const u32x4 pv = (u32x4){pw[0], pw[1], pw[2], pw[3]};
#pragma unroll
                    for (int dt = 0; dt < 8; ++dt) {
                        const u32x2 lo = lds_tr16(vtr + (2 * p) * 16 * 144 + dt * 16);
                        const u32x2 hi = lds_tr16(vtr + (2 * p + 1) * 16 * 144 + dt * 16);
                        const u32x4 av = (u32x4){lo.x, lo.y, hi.x, hi.y};
                        o[dt] = __builtin_amdgcn_mfma_f32_16x16x32_bf16(__builtin_bit_cast(bf16x8, av), __builtin_bit_cast(bf16x8, pv), o[dt], 0, 0, 0); }
                    wdone = __all(R < -150.05f) ? 1 : 0;
                }
            }
            later = R;
        }
        if (__syncthreads_and(wdone) || j == 0) break;
    }
    u32x2 rr[8];
#pragma unroll
    for (int dt = 0; dt < 8; ++dt) { const u32x2 g = gq[dt];
        rr[dt].x = cvt_pk_bf16(o[dt][0] * siluf_(bf_lo(g.x)), o[dt][1] * siluf_(bf_hi(g.x))); rr[dt].y = cvt_pk_bf16(o[dt][2] * siluf_(bf_lo(g.y)), o[dt][3] * siluf_(bf_hi(g.y))); }
    store_row_tiles(mk_rsrc(Y01), (int)((qrow * 1024 + h * 128) * 2), rr, lane, quad);
}

__device__ __forceinline__ void xa_stage(LAS unsigned char* lds, const bf16_t* __restrict__ KV  , const int h) {
    const int tid = tid_();
    LAS bf16_t* Kms = (LAS bf16_t*)lds;
    LAS bf16_t* Vm = Kms + 256 * 136;
    for (int c = tid; c < 4096; c += 512) { const int r = c >> 4, cc = c & 15;
        const bf16_t* kp = KV + (size_t)r * 1024 + h * 128 + cc * 8;
        *(LAS u32x4*)(Kms + r * 136 + cc * 8) = *(const u32x4*)kp; *(LAS u32x4*)(Vm + r * 144 + cc * 8) = *(const u32x4*)(kp + 512); }
}
__device__ __forceinline__ void xa_tile(LAS unsigned char* lds, const bf16_t* __restrict__ P, bf16_t* __restrict__ Y23, const int h, const int tile) {
    const int tid = tid_(), lane = tid & 63, w = tid >> 6, ql = lane & 15, quad = lane >> 4;
    const LAS bf16_t* Kms = (const LAS bf16_t*)lds;
    const LAS bf16_t* vtr = Kms + 256 * 136 + (quad * 4 + (ql >> 2)) * 144 + 4 * (ql & 3);
    const size_t qrow = (size_t)tile * 128 + w * 16 + ql;
    const float scale = 0.08838834764831845f;
    bf16x8 qf[4];
#pragma unroll
    for (int ks = 0; ks < 4; ++ks) qf[ks] = *(const bf16x8*)(P + qrow * PW + 4096 + h * 128 + ks * 32 + quad * 8);
    f32x4 s[16];
#pragma unroll
    for (int kt = 0; kt < 16; ++kt) { s[kt] = (f32x4){0.f, 0.f, 0.f, 0.f};
#pragma unroll
        for (int ks = 0; ks < 4; ++ks) { const bf16x8 a = *(const LAS bf16x8*)(Kms + (kt * 16 + ql) * 136 + ks * 32 + quad * 8);
            s[kt] = __builtin_amdgcn_mfma_f32_16x16x32_bf16(a, qf[ks], s[kt], 0, 0, 0); } }
    float m = -3.0e38f;
#pragma unroll
    for (int kt = 0; kt < 16; ++kt)
#pragma unroll
        for (int e = 0; e < 4; ++e) m = fmaxf(m, s[kt][e]);
    m = fmaxf(m, bperm((lane ^ (16)) << 2, m)); m = fmaxf(m, bperm((lane ^ (32)) << 2, m));
    float sum = 0.f; unsigned pw[32];
#pragma unroll
    for (int kt = 0; kt < 16; ++kt) { float p[4];
#pragma unroll
        for (int e = 0; e < 4; ++e) { p[e] = __builtin_amdgcn_exp2f((s[kt][e] - m) * (scale * 1.4426950408889634f)); sum += p[e]; }
        pw[kt * 2] = cvt_pk_bf16(p[0], p[1]); pw[kt * 2 + 1] = cvt_pk_bf16(p[2], p[3]); }
    sum += bperm((lane ^ (16)) << 2, sum); sum += bperm((lane ^ (32)) << 2, sum);
    const float inv = 1.0f / sum;
    f32x4 o[8];
#pragma unroll
    for (int dt = 0; dt < 8; ++dt) { o[dt] = (f32x4){0.f, 0.f, 0.f, 0.f};
#pragma unroll
        for (int ks = 0; ks < 8; ++ks) {
            const u32x2 lo = lds_tr16(vtr + (2 * ks) * 16 * 144 + dt * 16);
            const u32x2 hi = lds_tr16(vtr + (2 * ks + 1) * 16 * 144 + dt * 16);
            const u32x4 av = (u32x4){lo.x, lo.y, hi.x, hi.y};
            const u32x4 pv = (u32x4){pw[4 * ks], pw[4 * ks + 1], pw[4 * ks + 2], pw[4 * ks + 3]};
            o[dt] = __builtin_amdgcn_mfma_f32_16x16x32_bf16(__builtin_bit_cast(bf16x8, av), __builtin_bit_cast(bf16x8, pv), o[dt], 0, 0, 0); } }
    u32x2 rr[8];
#pragma unroll
    for (int dt = 0; dt < 8; ++dt) { const int d = dt * 16 + quad * 4;
        const u32x2 g = *(const u32x2*)(P + qrow * PW + 4608 + h * 128 + d);
        rr[dt].x = cvt_pk_bf16(o[dt][0] * inv * siluf_(bf_lo(g.x)), o[dt][1] * inv * siluf_(bf_hi(g.x)));
        rr[dt].y = cvt_pk_bf16(o[dt][2] * inv * siluf_(bf_lo(g.y)), o[dt][3] * inv * siluf_(bf_hi(g.y))); }
    store_row_tiles(mk_rsrc(Y23), (int)((qrow * 1024 + 512 + h * 128) * 2), rr, lane, quad);
}

__device__ __forceinline__ void pool_stage(LAS unsigned char* lds, const bf16_t* __restrict__ Wp  ) {
    LAS bf16_t* Ws = (LAS bf16_t*)lds;
    for (int c = tid_(); c < 2048; c += 512) { const int r = c >> 4, cc = c & 15; *(LAS u32x4*)(Ws + r * 136 + cc * 8) = *(const u32x4*)(Wp + r * 128 + cc * 8); }
}
template <int WIN>
__device__ __forceinline__ void pool_tile_w(LAS unsigned char* lds, const bf16_t* __restrict__ P, bf16_t* __restrict__ Y01, const float* __restrict__ pscale, const int g, const int tile) {
    const int tid = tid_(), lane = tid & 63, w = tid >> 6, ql = lane & 15, quad = lane >> 4;
    const LAS bf16_t* Ws = (const LAS bf16_t*)lds;
    LAS bf16_t* U = (LAS bf16_t*)(lds + 34816);
    u32x2 gq[8];
#pragma unroll
    for (int jt = 0; jt < 8; ++jt) gq[jt] = *(const u32x2*)(P + (size_t)(tile * 128 + w * 16 + ql) * PW + 2560 + g * 128 + jt * 16 + quad * 4);
    __syncthreads();
    for (int c = tid; c < 143 * 16; c += 512) { const int r = c >> 4, cc = c & 15; const int grow = tile * 128 - 15 + r;
        u32x4 v = (u32x4){0u, 0u, 0u, 0u};
        if (grow >= 0) v = *(const u32x4*)(P + (size_t)grow * PW + 2048 + g * 128 + cc * 8);
        *(LAS u32x4*)(U + r * 136 + cc * 8) = v; }
    __syncthreads();
    const int pos = tile * 128 + w * 16 + ql, lrow = 15 + w * 16 + ql;
    const int cnt = (pos + 1 < WIN) ? pos + 1 : WIN; const float rc = rcp_((float)cnt);
    bf16x8 bfm[4];
#pragma unroll
    for (int ks = 0; ks < 4; ++ks) {
        const LAS bf16_t* up = U + lrow * 136 + ks * 32 + quad * 8;
        const u32x4 c0 = *(const LAS u32x4*)up;
        const float a[8] = {bf_lo(c0.x), bf_hi(c0.x), bf_lo(c0.y), bf_hi(c0.y), bf_lo(c0.z), bf_hi(c0.z), bf_lo(c0.w), bf_hi(c0.w)};
        float sm[8];
#pragma unroll
        for (int e = 0; e < 8; ++e) sm[e] = a[e];
#pragma unroll
        for (int t = 1; t < WIN; ++t) { const u32x4 c1 = *(const LAS u32x4*)(up - t * 136);
            sm[0] += bf_lo(c1.x); sm[1] += bf_hi(c1.x); sm[2] += bf_lo(c1.y); sm[3] += bf_hi(c1.y); sm[4] += bf_lo(c1.z); sm[5] += bf_hi(c1.z); sm[6] += bf_lo(c1.w); sm[7] += bf_hi(c1.w); }
        u32x4 pk; pk.x = cvt_pk_bf16(sm[0] * rc - a[0], sm[1] * rc - a[1]); pk.y = cvt_pk_bf16(sm[2] * rc - a[2], sm[3] * rc - a[3]);
        pk.z = cvt_pk_bf16(sm[4] * rc - a[4], sm[5] * rc - a[5]); pk.w = cvt_pk_bf16(sm[6] * rc - a[6], sm[7] * rc - a[7]);
        bfm[ks] = __builtin_bit_cast(bf16x8, pk);
    }
    u32x2 rr[8];
#pragma unroll
    for (int jt = 0; jt < 8; ++jt) { f32x4 acc = (f32x4){0.f, 0.f, 0.f, 0.f};
#pragma unroll
        for (int ks = 0; ks < 4; ++ks) { const bf16x8 a = *(const LAS bf16x8*)(Ws + (jt * 16 + ql) * 136 + ks * 32 + quad * 8);
            acc = __builtin_amdgcn_mfma_f32_16x16x32_bf16(a, bfm[ks], acc, 0, 0, 0); }
        const int j = g * 128 + jt * 16 + quad * 4;
        const f32x4 ps = *(const f32x4*)(pscale + j);
        const u32x2 gg = gq[jt];
        rr[jt].x = cvt_pk_bf16(acc[0] * ps[0] * siluf_(bf_lo(gg.x)), acc[1] * ps[1] * siluf_(bf_hi(gg.x)));
        rr[jt].y = cvt_pk_bf16(acc[2] * ps[2] * siluf_(bf_lo(gg.y)), acc[3] * ps[3] * siluf_(bf_hi(gg.y))); }
    store_row_tiles(mk_rsrc(Y01), (pos * 1024 + 512 + g * 128) * 2, rr, lane, quad);
}
__device__ __forceinline__ void pool_tile(LAS unsigned char* lds, const bf16_t* __restrict__ P, bf16_t* __restrict__ Y01, const float* __restrict__ pscale, const int g, const int tile) {
    if (g == 0) pool_tile_w<2>(lds, P, Y01, pscale, g, tile);
    else if (g == 1) pool_tile_w<4>(lds, P, Y01, pscale, g, tile);
    else if (g == 2) pool_tile_w<8>(lds, P, Y01, pscale, g, tile);
    else pool_tile_w<16>(lds, P, Y01, pscale, g, tile);
}

#define XB_TMO      128
#define XB_XCNT(j)  (256  + 64 * (j))
#define XB_XSUB(j)  (1280 + 64 * (j))
#define XB_XGEN(j)  (2304 + 64 * (j))
#define XB_TOP      3328
#define XB_TOPGEN   3392
#define XCD_BAR_WORDS 3456
#define XB_SPIN_CAP (1u << 22)
__device__ __forceinline__ unsigned xb_ld(unsigned* p)              { return __hip_atomic_load(p, __ATOMIC_RELAXED, __HIP_MEMORY_SCOPE_AGENT); }
__device__ __forceinline__ unsigned xb_add(unsigned* p, unsigned v) { return __hip_atomic_fetch_add(p, v, __ATOMIC_RELAXED, __HIP_MEMORY_SCOPE_AGENT); }
__device__ __forceinline__ unsigned xb_xcc_id() { return (unsigned)__builtin_amdgcn_s_getreg((3 << 11) | 20) & 0xFu; }
#define XB_SPIN(cond, bar) do { unsigned _sp = 0; while (cond) { __builtin_amdgcn_s_sleep(1); \
    if ((++_sp & 255u) == 0u) { if (xb_ld(&(bar)[XB_TMO])) break; if (_sp > XB_SPIN_CAP) { atomicAdd(&(bar)[XB_TMO], 1u); break; } } } } while (0)
__device__ __forceinline__ void xcd_barrier_complete(unsigned* bar, unsigned x, unsigned& nloc, unsigned& nx) {
    const unsigned G = gridDim.x * gridDim.y * gridDim.z;
    unsigned sum, cnt, mine, sp = 0u;
    for (;;) {
        sum = 0u; cnt = 0u; mine = 0u;
#pragma unroll
        for (unsigned j = 0; j < 16; ++j) { const unsigned c = xb_ld(&bar[XB_XCNT(j)]); sum += c; cnt += (c > 0u) ? 1u : 0u; mine = (j == x) ? c : mine; }
        if (sum == G) break;
        __builtin_amdgcn_s_sleep(1);
        if ((++sp & 255u) == 0u) { if (xb_ld(&bar[XB_TMO])) break; if (sp > XB_SPIN_CAP) { atomicAdd(&bar[XB_TMO], 1u); break; } }
    }
    nloc = mine > 0u ? mine : 1u; nx = cnt > 0u ? cnt : 1u;
}
__device__ __forceinline__ void xcd_barrier(unsigned* bar, volatile LAS unsigned* st) {
    asm volatile("s_waitcnt vmcnt(0)" ::: "memory");
    __syncthreads();
    if (tid_() == 0) {
        const unsigned x = xb_xcc_id();
        __builtin_amdgcn_s_waitcnt(0);
        unsigned nloc = st[0], nx = st[1];
        if (nloc == 0u) { xcd_barrier_complete(bar, x, nloc, nx); st[0] = nloc; st[1] = nx; }
        const unsigned old = xb_add(&bar[XB_XSUB(x)], 1u);
        const unsigned gen = old / nloc;
        if (old + 1u == (gen + 1u) * nloc) {
            __builtin_amdgcn_fence(__ATOMIC_RELEASE, "agent");
            asm volatile("s_waitcnt vmcnt(0)" ::: "memory");
            const unsigned og = xb_add(&bar[XB_TOP], 1u);
            const unsigned tg = og / nx;
            if (og + 1u == (tg + 1u) * nx) xb_add(&bar[XB_TOPGEN], 1u);
            else XB_SPIN(xb_ld(&bar[XB_TOPGEN]) == tg, bar);
            __builtin_amdgcn_fence(__ATOMIC_ACQUIRE, "agent");
            xb_add(&bar[XB_XGEN(x)], 1u);
            asm volatile("s_waitcnt vmcnt(0)" ::: "memory");
        } else {
            XB_SPIN(xb_ld(&bar[XB_XGEN(x)]) == gen, bar);
            __builtin_amdgcn_fence(__ATOMIC_ACQUIRE, "agent");
            asm volatile("s_waitcnt vmcnt(0)" ::: "memory");
        }
    }
    __syncthreads();
}


__device__ __forceinline__ void flag_arrive(unsigned* cnt) {
    asm volatile("s_waitcnt vmcnt(0)" ::: "memory"); __syncthreads();
    if (tid_() == 0) { __builtin_amdgcn_fence(__ATOMIC_RELEASE, "agent"); asm volatile("s_waitcnt vmcnt(0)" ::: "memory"); (void)xb_add(cnt, 1u); }
}
__device__ __forceinline__ void flag_wait_nf(unsigned* cnt, unsigned target, unsigned* bar) {
    if (tid_() == 0) { XB_SPIN(xb_ld(cnt) < target, bar); }
    __syncthreads();
}
__device__ __forceinline__ float ld_agent(const float* p) { return __hip_atomic_load(p, __ATOMIC_RELAXED, __HIP_MEMORY_SCOPE_AGENT); }
__device__ __forceinline__ void flag_arrive_wt(unsigned* cnt) {
    asm volatile("s_waitcnt vmcnt(0)" ::: "memory"); __syncthreads();
    if (tid_() == 0) (void)xb_add(cnt, 1u);
}
__device__ __forceinline__ void flag_wait(unsigned* cnt, unsigned target, unsigned* bar) {
    if (tid_() == 0) { XB_SPIN(xb_ld(cnt) < target, bar); __builtin_amdgcn_fence(__ATOMIC_ACQUIRE, "agent"); asm volatile("s_waitcnt vmcnt(0)" ::: "memory"); }
    __syncthreads();
}
__device__ __forceinline__ void fold4(const float* base, const int n, const int quad, const int ql, float (&Po)[4], float (&Ho)[4]) {
    const int seg = (n + 3) >> 2, i0 = quad * seg; int i1 = i0 + seg; if (i1 > n) i1 = n;
    float Ps[4] = {1.f, 1.f, 1.f, 1.f}, Hs[4] = {0.f, 0.f, 0.f, 0.f};
#pragma unroll 4
    for (int i = i0; i < i1; ++i) {
#pragma unroll
        for (int nt = 0; nt < 4; ++nt) { const float a = ld_agent(base + (size_t)i * 1024 + nt * 16), bb = ld_agent(base + (size_t)i * 1024 + 512 + nt * 16); Hs[nt] = a * Hs[nt] + bb; Ps[nt] *= a; } }
#pragma unroll
    for (int nt = 0; nt < 4; ++nt) {
        const float P0 = bperm((ql) << 2, Ps[nt]), P1 = bperm((ql + 16) << 2, Ps[nt]), P2 = bperm((ql + 32) << 2, Ps[nt]), P3 = bperm((ql + 48) << 2, Ps[nt]);
        const float H0 = bperm((ql) << 2, Hs[nt]), H1 = bperm((ql + 16) << 2, Hs[nt]), H2 = bperm((ql + 32) << 2, Hs[nt]), H3 = bperm((ql + 48) << 2, Hs[nt]);
        Po[nt] = (P0 * P1) * (P2 * P3); Ho[nt] = ((H0 * P1 + H1) * P2 + H2) * P3 + H3; }
}

__device__ __forceinline__ void lru_stage(LAS unsigned char* lds, const float* cw, const float* cb, const float* brg, const float* big, const float* L) {
    LAS float* F = (LAS float*)lds;
    for (int i = tid_(); i < 2048; i += 512) F[i] = cw[i];
    { const int i = tid_(); F[2048 + i] = cb[i]; F[2560 + i] = brg[i]; F[3072 + i] = big[i];
      const float l = -L[i]; F[3584 + i] = fmaxf(l, 0.f) + log1pf(__expf(-fabsf(l))); }
}
template <bool FINAL>
__device__ __forceinline__ void lru_unit(LAS unsigned char* lds, const bf16_t* __restrict__ P, bf16_t* __restrict__ Y23, float* __restrict__ AGG, const float* __restrict__ GAGG,
                                         const bf16_t* __restrict__ Wrg, const bf16_t* __restrict__ Wig, unsigned char* __restrict__ cache, const int tile) {
    const int tid = tid_(), lane = tid & 63, hd = tid >> 6, ql = lane & 15, quad = lane >> 4;
    const LAS float* F = (const LAS float*)lds;
    LAS float* XC = (LAS float*)(lds + 16384 + hd * 7168);
    bf16x8 wr_[4][2], wi_[4][2];
#pragma unroll
    for (int nt = 0; nt < 4; ++nt)
#pragma unroll
        for (int ks = 0; ks < 2; ++ks) { const size_t o = (size_t)(hd * 64 + nt * 16 + ql) * 64 + ks * 32 + quad * 8;
            wr_[nt][ks] = *(const bf16x8*)(Wrg + o); wi_[nt][ks] = *(const bf16x8*)(Wig + o); }
    float hst[4] = {0.f, 0.f, 0.f, 0.f}, ptot[4] = {1.f, 1.f, 1.f, 1.f};
    if (FINAL) {
        float Pa[4], Ha[4], Pb[4], Hb[4];
        fold4(GAGG + hd * 64 + ql, tile >> 4, quad, ql, Pa, Ha);
        fold4(AGG + (size_t)(tile & ~15) * 1024 + hd * 64 + ql, tile & 15, quad, ql, Pb, Hb);
#pragma unroll
        for (int nt = 0; nt < 4; ++nt) hst[nt] = Pb[nt] * Ha[nt] + Hb[nt];
    }
    const int tk = lane >> 2, cg4 = (lane & 3) * 16, cb0 = hd * 64 + cg4;
    LAS bf16_t* UB = (LAS bf16_t*)(lds + 16384 + hd * 7168 + 4352);
    u32x4 pu[3];
    const int lrow = lane >> 3, lch = (lane & 7) * 8;
#define LRU_LOADU(T0) do { const bf16_t* ub_ = P + 3072 + hd * 64 + lch; \
        pu[0] = *(const u32x4*)(ub_ + (size_t)((T0) + lrow) * PW); pu[1] = *(const u32x4*)(ub_ + (size_t)((T0) + 8 + lrow) * PW); \
        { const int p = (T0) - 3 + lrow; pu[2] = (lane < 24 && p >= 0) ? *(const u32x4*)(ub_ + (size_t)(p < 0 ? 0 : p) * PW) : (u32x4){0u, 0u, 0u, 0u}; } } while (0)
    LRU_LOADU(tile * 64);
    for (int sub = 0; sub < 4; ++sub) {
        const int t0 = tile * 64 + sub * 16;
        {
            LDS_WAIT();
            *(LAS u32x4*)(UB + (3 + lrow) * 72 + lch) = pu[0]; *(LAS u32x4*)(UB + (11 + lrow) * 72 + lch) = pu[1];
            if (lane < 24) *(LAS u32x4*)(UB + lrow * 72 + lch) = pu[2];
            LDS_WAIT();
            if (sub < 3) LRU_LOADU(t0 + 16);
            float xc[16];
#pragma unroll
            for (int e = 0; e < 16; ++e) xc[e] = F[2048 + cb0 + e];
#pragma unroll
            for (int tap = 0; tap < 4; ++tap) {
                const u32x4 u0 = *(const LAS u32x4*)(UB + (tk + tap) * 72 + cg4), u1 = *(const LAS u32x4*)(UB + (tk + tap) * 72 + cg4 + 8);
                const float uv[16] = {bf_lo(u0.x), bf_hi(u0.x), bf_lo(u0.y), bf_hi(u0.y), bf_lo(u0.z), bf_hi(u0.z), bf_lo(u0.w), bf_hi(u0.w),
                                      bf_lo(u1.x), bf_hi(u1.x), bf_lo(u1.y), bf_hi(u1.y), bf_lo(u1.z), bf_hi(u1.z), bf_lo(u1.w), bf_hi(u1.w)};
#pragma unroll
                for (int e = 0; e < 16; ++e) xc[e] += F[tap * 512 + cb0 + e] * uv[e]; }
#pragma unroll
            for (int q = 0; q < 4; ++q) *(LAS f32x4*)(XC + tk * 68 + cg4 + q * 4) = (f32x4){xc[q * 4], xc[q * 4 + 1], xc[q * 4 + 2], xc[q * 4 + 3]};
            LDS_WAIT();
        }
        bf16x8 af[2];
#pragma unroll
        for (int ks = 0; ks < 2; ++ks) { const f32x4 a0 = *(const LAS f32x4*)(XC + ql * 68 + ks * 32 + quad * 8), a1 = *(const LAS f32x4*)(XC + ql * 68 + ks * 32 + quad * 8 + 4);
            u32x4 pk; pk.x = cvt_pk_bf16(a0[0], a0[1]); pk.y = cvt_pk_bf16(a0[2], a0[3]); pk.z = cvt_pk_bf16(a1[0], a1[1]); pk.w = cvt_pk_bf16(a1[2], a1[3]);
            af[ks] = __builtin_bit_cast(bf16x8, pk); }
#pragma unroll
        for (int nt = 0; nt < 4; ++nt) {
            f32x4 ar = (f32x4){0.f, 0.f, 0.f, 0.f}, ai = (f32x4){0.f, 0.f, 0.f, 0.f};
#pragma unroll
            for (int ks = 0; ks < 2; ++ks) { ar = __builtin_amdgcn_mfma_f32_16x16x32_bf16(af[ks], wr_[nt][ks], ar, 0, 0, 0); ai = __builtin_amdgcn_mfma_f32_16x16x32_bf16(af[ks], wi_[nt][ks], ai, 0, 0, 0); }
            const int c = hd * 64 + nt * 16 + ql;
            const float brg = F[2560 + c], big = F[3072 + c], spl = F[3584 + c];
            float av[4], bv[4]; unsigned cpk[4];
#pragma unroll
            for (int e = 0; e < 4; ++e) { const float xcv = XC[(quad * 4 + e) * 68 + nt * 16 + ql];
                const float r = sigmoidf_(ar[e] + brg), ig = sigmoidf_(ai[e] + big);
                const float la = -8.0f * r * spl; const float a = __expf(la);
                const float om = fmaxf(1.0f - a * a, 0.0f);
                const unsigned pkv = cvt_pk_bf16(la, __builtin_amdgcn_sqrtf(om) * ig * xcv); cpk[e] = pkv;
                av[e] = FINAL ? a : __expf(bf_lo(pkv)); bv[e] = bf_hi(pkv); }
            if (!FINAL) *(u32x4*)(cache + ((size_t)((sub * 4 + nt) * 512 + tid)) * 16) = (u32x4){cpk[0], cpk[1], cpk[2], cpk[3]};
            const float Pq = (av[0] * av[1]) * (av[2] * av[3]);
            const float Hq = ((bv[0] * av[1] + bv[1]) * av[2] + bv[2]) * av[3] + bv[3];
            const float P0 = bperm((ql) << 2, Pq), P1 = bperm((ql + 16) << 2, Pq), P2 = bperm((ql + 32) << 2, Pq), P3 = bperm((ql + 48) << 2, Pq);
            const float H0 = bperm((ql) << 2, Hq), H1 = bperm((ql + 16) << 2, Hq), H2 = bperm((ql + 32) << 2, Hq), H3 = bperm((ql + 48) << 2, Hq);
            const float c0 = hst[nt], c1 = P0 * c0 + H0, c2 = P1 * c1 + H1, c3 = P2 * c2 + H2;
            if (FINAL) {
                float hh = quad == 0 ? c0 : (quad == 1 ? c1 : (quad == 2 ? c2 : c3));
#pragma unroll
                for (int e = 0; e < 4; ++e) { hh = av[e] * hh + bv[e]; XC[(quad * 4 + e) * 68 + nt * 16 + ql] = hh; }
            }
            hst[nt] = P3 * c3 + H3; ptot[nt] *= (P0 * P1) * (P2 * P3);
        }
        if (FINAL) {
            LDS_WAIT();
            const size_t row = (size_t)t0 + tk;
            const bf16_t* gp = P + row * PW + 3584 + cb0; const u32x4 g0 = *(const u32x4*)gp, g1 = *(const u32x4*)(gp + 8);
            const f32x4 h0 = *(const LAS f32x4*)(XC + tk * 68 + cg4), h1 = *(const LAS f32x4*)(XC + tk * 68 + cg4 + 4), h2 = *(const LAS f32x4*)(XC + tk * 68 + cg4 + 8), h3 = *(const LAS f32x4*)(XC + tk * 68 + cg4 + 12);
            u32x4 o0, o1;
            o0.x = cvt_pk_bf16(h0[0] * siluf_(bf_lo(g0.x)), h0[1] * siluf_(bf_hi(g0.x))); o0.y = cvt_pk_bf16(h0[2] * siluf_(bf_lo(g0.y)), h0[3] * siluf_(bf_hi(g0.y)));
            o0.z = cvt_pk_bf16(h1[0] * siluf_(bf_lo(g0.z)), h1[1] * siluf_(bf_hi(g0.z))); o0.w = cvt_pk_bf16(h1[2] * siluf_(bf_lo(g0.w)), h1[3] * siluf_(bf_hi(g0.w)));
            o1.x = cvt_pk_bf16(h2[0] * siluf_(bf_lo(g1.x)), h2[1] * siluf_(bf_hi(g1.x))); o1.y = cvt_pk_bf16(h2[2] * siluf_(bf_lo(g1.y)), h2[3] * siluf_(bf_hi(g1.y)));
            o1.z = cvt_pk_bf16(h3[0] * siluf_(bf_lo(g1.z)), h3[1] * siluf_(bf_hi(g1.z))); o1.w = cvt_pk_bf16(h3[2] * siluf_(bf_lo(g1.w)), h3[3] * siluf_(bf_hi(g1.w)));
            bf16_t* yp = Y23 + row * 1024 + cb0; *(u32x4*)yp = o0; *(u32x4*)(yp + 8) = o1;
        }
    }
    if (!FINAL && quad == 0) {
#pragma unroll
        for (int nt = 0; nt < 4; ++nt) { const int c = hd * 64 + nt * 16 + ql; __hip_atomic_store(AGG + (size_t)tile * 1024 + c, ptot[nt], __ATOMIC_RELAXED, __HIP_MEMORY_SCOPE_AGENT); __hip_atomic_store(AGG + (size_t)tile * 1024 + 512 + c, hst[nt], __ATOMIC_RELAXED, __HIP_MEMORY_SCOPE_AGENT); }
    }
}


__device__ __forceinline__ void lru_final(LAS unsigned char* lds, const bf16_t* __restrict__ P, bf16_t* __restrict__ Y23, const float* __restrict__ AGG, const float* __restrict__ GAGG,
                                          const unsigned char* __restrict__ cache, const int tile) {
    const int tid = tid_(), lane = tid & 63, hd = tid >> 6, ql = lane & 15, quad = lane >> 4;
    LAS float* XC = (LAS float*)(lds + hd * 4352);
    float hst[4];
    {   float Pa[4], Ha[4], Pb[4], Hb[4];
        fold4(GAGG + hd * 64 + ql, tile >> 4, quad, ql, Pa, Ha);
        fold4(AGG + (size_t)(tile & ~15) * 1024 + hd * 64 + ql, tile & 15, quad, ql, Pb, Hb);
#pragma unroll
        for (int nt = 0; nt < 4; ++nt) hst[nt] = Pb[nt] * Ha[nt] + Hb[nt]; }
    const int tk = lane >> 2, cg4 = (lane & 3) * 16, cb0 = hd * 64 + cg4;
    u32x4 pk[4];
#pragma unroll
    for (int nt = 0; nt < 4; ++nt) pk[nt] = *(const u32x4*)(cache + ((size_t)(nt * 512 + tid)) * 16);
    for (int sub = 0; sub < 4; ++sub) {
        const int t0 = tile * 64 + sub * 16;
        const size_t row = (size_t)t0 + tk;
        const bf16_t* gp = P + row * PW + 3584 + cb0; const u32x4 g0 = *(const u32x4*)gp, g1 = *(const u32x4*)(gp + 8);
        u32x4 cur[4];
#pragma unroll
        for (int nt = 0; nt < 4; ++nt) cur[nt] = pk[nt];
        if (sub < 3) {
#pragma unroll
            for (int nt = 0; nt < 4; ++nt) pk[nt] = *(const u32x4*)(cache + ((size_t)(((sub + 1) * 4 + nt) * 512 + tid)) * 16); }
        LDS_WAIT();
#pragma unroll
        for (int nt = 0; nt < 4; ++nt) {
            const unsigned cw[4] = {cur[nt].x, cur[nt].y, cur[nt].z, cur[nt].w};
            float av[4], bv[4];
#pragma unroll
            for (int e = 0; e < 4; ++e) { av[e] = __expf(bf_lo(cw[e])); bv[e] = bf_hi(cw[e]); }
            const float Pq = (av[0] * av[1]) * (av[2] * av[3]);
            const float Hq = ((bv[0] * av[1] + bv[1]) * av[2] + bv[2]) * av[3] + bv[3];
            const float P0 = bperm((ql) << 2, Pq), P1 = bperm((ql + 16) << 2, Pq), P2 = bperm((ql + 32) << 2, Pq), P3 = bperm((ql + 48) << 2, Pq);
            const float H0 = bperm((ql) << 2, Hq), H1 = bperm((ql + 16) << 2, Hq), H2 = bperm((ql + 32) << 2, Hq), H3 = bperm((ql + 48) << 2, Hq);
            const float c0 = hst[nt], c1 = P0 * c0 + H0, c2 = P1 * c1 + H1, c3 = P2 * c2 + H2;
            float hh = quad == 0 ? c0 : (quad == 1 ? c1 : (quad == 2 ? c2 : c3));
#pragma unroll
            for (int e = 0; e < 4; ++e) { hh = av[e] * hh + bv[e]; XC[(quad * 4 + e) * 68 + nt * 16 + ql] = hh; }
            hst[nt] = P3 * c3 + H3;
        }
        LDS_WAIT();
        const f32x4 h0 = *(const LAS f32x4*)(XC + tk * 68 + cg4), h1 = *(const LAS f32x4*)(XC + tk * 68 + cg4 + 4), h2 = *(const LAS f32x4*)(XC + tk * 68 + cg4 + 8), h3 = *(const LAS f32x4*)(XC + tk * 68 + cg4 + 12);
        u32x4 o0, o1;
        o0.x = cvt_pk_bf16(h0[0] * siluf_(bf_lo(g0.x)), h0[1] * siluf_(bf_hi(g0.x))); o0.y = cvt_pk_bf16(h0[2] * siluf_(bf_lo(g0.y)), h0[3] * siluf_(bf_hi(g0.y)));
        o0.z = cvt_pk_bf16(h1[0] * siluf_(bf_lo(g0.z)), h1[1] * siluf_(bf_hi(g0.z))); o0.w = cvt_pk_bf16(h1[2] * siluf_(bf_lo(g0.w)), h1[3] * siluf_(bf_hi(g0.w)));
        o1.x = cvt_pk_bf16(h2[0] * siluf_(bf_lo(g1.x)), h2[1] * siluf_(bf_hi(g1.x))); o1.y = cvt_pk_bf16(h2[2] * siluf_(bf_lo(g1.y)), h2[3] * siluf_(bf_hi(g1.y)));
        o1.z = cvt_pk_bf16(h3[0] * siluf_(bf_lo(g1.z)), h3[1] * siluf_(bf_hi(g1.z))); o1.w = cvt_pk_bf16(h3[2] * siluf_(bf_lo(g1.w)), h3[3] * siluf_(bf_hi(g1.w)));
        bf16_t* yp = Y23 + row * 1024 + cb0; *(u32x4*)yp = o0; *(u32x4*)(yp + 8) = o1;
    }
}

typedef const __attribute__((address_space(4))) Args* ArgsP;
__device__ __forceinline__ ArgsP args_ptr() { ArgsP p = (ArgsP)__builtin_amdgcn_kernarg_segment_ptr(); asm volatile("" : "+s"(p)); return p; }
__global__ void __launch_bounds__(512, 2) mk_fwd(Args a_unused) {
    extern __shared__ __attribute__((aligned(16))) unsigned char lds_[];
    LAS unsigned char* lds = (LAS unsigned char*)lds_;
    cg::grid_group grid = cg::this_grid();
    volatile LAS unsigned* bst = (volatile LAS unsigned*)(lds + LDS_BARW);
    { ArgsP ap0 = args_ptr(); unsigned* bar0 = (unsigned*)(ap0->ws);
      if (tid_() == 0) { bst[0] = 0u; bst[1] = 0u; (void)xb_add(&bar0[XB_XCNT(xb_xcc_id())], 1u); } }
#define GRID_BAR() do { ArgsP apb = args_ptr(); xcd_barrier((unsigned*)(apb->ws), bst); } while (0)

    {
        __syncthreads();
        ArgsP ap = args_ptr(); unsigned char* ws = ap->ws;
        const int tid = tid_(), lane = tid & 63, wave = __builtin_amdgcn_readfirstlane(tid >> 6), c = bid_(), G = gridDim.x;
        bf16_t* Wpool_t = (bf16_t*)(ws + WS_SMALL); bf16_t* Wrg_t = (bf16_t*)(ws + WS_SMALL + 262144); bf16_t* Wig_t = (bf16_t*)(ws + WS_SMALL + 262144 + 131072);
        bf16_t* MEMB = (bf16_t*)(ws + WS_MEMB); bf16_t* Win_t = (bf16_t*)(ws + WS_WIN); bf16_t* Wb_t = (bf16_t*)(ws + WS_WB); bf16_t* Wo_t = (bf16_t*)(ws + WS_WO); bf16_t* Wkv_t = (bf16_t*)(ws + WS_WKV);
        bf16_t* XN = (bf16_t*)(ws + WS_XN);
        LAS float* scr = (LAS float*)(lds + wave * 16384);
        const int gw = c * 8 + wave, NGW = G * 8;
        constexpr int I_IN = 16 * 288, I_BR = 8 * 32, I_SQ = 16 * 32, I_PL = 2 * 4, I_RG = 1 * 2;
        constexpr int N_IN = 2 * I_IN, N_BR = 8 * I_BR, N_O = 2 * I_SQ, N_KV = 2 * I_SQ, N_PL = 8 * I_PL, N_RG = 16 * I_RG;
        constexpr int NITEMS = N_IN + N_BR + N_O + N_KV + N_PL + 2 * N_RG;
        for (int it = gw; it < NITEMS; it += NGW) {
            int r = it;
            if (r < N_IN) { const int l = r / I_IN; transpose_item(ap->w_in + (size_t)l * DM * NIN, DM, NIN, Win_t + (size_t)l * NIN * DM, DM, scr, r % I_IN, lane); continue; } r -= N_IN;
            if (r < N_BR) { const int q = r / I_BR; transpose_item(ap->w_branch + (size_t)q * 512 * DM, 512, DM, Wb_t + (size_t)q * 1024 * 1024, 1024, scr, r % I_BR, lane); continue; } r -= N_BR;
            if (r < N_O) { const int l = r / I_SQ; transpose_item(ap->w_out + (size_t)l * DM * DM, DM, DM, Wo_t + (size_t)l * DM * DM, DM, scr, r % I_SQ, lane); continue; } r -= N_O;
            if (r < N_KV) { const int l = r / I_SQ; transpose_item(ap->w_mem_kv + (size_t)l * DM * DM, DM, DM, Wkv_t + (size_t)l * DM * DM, DM, scr, r % I_SQ, lane); continue; } r -= N_KV;
            if (r < N_PL) { const int q = r / I_PL; transpose_item(ap->w_pool + (size_t)q * 128 * 128, 128, 128, Wpool_t + (size_t)q * 128 * 128, 128, scr, r % I_PL, lane); continue; } r -= N_PL;
            if (r < N_RG) { const int q = r / I_RG; transpose_item(ap->w_rg + (size_t)q * 64 * 64, 64, 64, Wrg_t + (size_t)q * 64 * 64, 64, scr, r % I_RG, lane); continue; } r -= N_RG;
            { const int q = r / I_RG; transpose_item(ap->w_ig + (size_t)q * 64 * 64, 64, 64, Wig_t + (size_t)q * 64 * 64, 64, scr, r % I_RG, lane); }
        }
        const float* x = ap->x; const float* mem = ap->mem;
        const size_t gt = (size_t)c * 512 + tid, GT = (size_t)G * 512;
        for (size_t i = gt; i < (size_t)NBATCH * SEQ * DM / 8; i += 4 * GT) {
            f32x4 v0[4], v1[4];
#pragma unroll
            for (int q = 0; q < 4; ++q) { v0[q] = *(const f32x4*)(x + (i + q * GT) * 8); v1[q] = *(const f32x4*)(x + (i + q * GT) * 8 + 4); }
#pragma unroll
            for (int q = 0; q < 4; ++q) { u32x4 o; o.x = cvt_pk_bf16(v0[q][0], v0[q][1]); o.y = cvt_pk_bf16(v0[q][2], v0[q][3]); o.z = cvt_pk_bf16(v1[q][0], v1[q][1]); o.w = cvt_pk_bf16(v1[q][2], v1[q][3]);
                *(u32x4*)(XN + (i + q * GT) * 8) = o; } }
        for (size_t i = gt; i < (size_t)NBATCH * MEMLEN * DM / 8; i += GT) { const f32x4 v0 = *(const f32x4*)(mem + i * 8), v1 = *(const f32x4*)(mem + i * 8 + 4);
            u32x4 o; o.x = pk2(v0[0], v0[1]); o.y = pk2(v0[2], v0[3]); o.z = pk2(v1[0], v1[1]); o.w = pk2(v1[2], v1[3]); *(u32x4*)(MEMB + i * 8) = o; }
    }
    if (gridDim.x == 0x7fffffffu) grid.sync();
    GRID_BAR();

    for (int l = 0; l < NLAYER; ++l) {
        for (int b = 0; b < NBATCH; ++b) {
            {
                __syncthreads();
                ArgsP ap = args_ptr(); unsigned char* ws = ap->ws; const int c = bid_();
                SchedP1 S{(const char*)(ws + WS_XN) + (size_t)b * SEQ * DM * 2, (const char*)(ws + WS_WIN) + (size_t)l * NIN * DM * 2, c};
                EpiP1 E{(bf16_t*)(ws + WS_PROJ), PW};
                pg8::gemm_phase<EpiP1, SchedP1, true>(lds, 2048, 2048, S, E);
            }
            if (l == 0 && b == 0) {
                ArgsP ap = args_ptr(); unsigned char* ws = ap->ws; const int c = bid_();
                __syncthreads();
                SchedKV S{(const char*)(ws + WS_MEMB), (const char*)(ws + WS_WKV), c};
                EpiP1 E{(bf16_t*)(ws + WS_KVM) + (size_t)(c >> 3) * 512 * 1024, 1024};
                pg8::gemm_phase<EpiP1, SchedKV, true>(lds, 2048, 2048, S, E);
            }
            GRID_BAR();
            {
                ArgsP ap = args_ptr(); unsigned char* ws = ap->ws; const int c = bid_();
                const bf16_t* PROJ = (const bf16_t*)(ws + WS_PROJ); bf16_t* Y23 = (bf16_t*)(ws + WS_Y) + (size_t)16384 * 1024;
                float* AGG = (float*)(ws + WS_AGG); float* GAGG = AGG + 256 * 1024;
                unsigned* bar = (unsigned*)ws; unsigned* cnt1 = bar + 3584 + 64 * (l * 2 + b); unsigned* cnt2 = bar + 3584 + 64 * (4 + l * 2 + b);
                __syncthreads();
                lru_stage(lds, ap->conv_w + (size_t)l * 2048, ap->conv_b + l * 512, ap->b_rg + l * 512, ap->b_ig + l * 512, ap->lru_L + l * 512);
                __syncthreads();
                lru_unit<false>(lds, PROJ, Y23, AGG, GAGG, (const bf16_t*)(ws + WS_SMALL + 262144) + (size_t)l * 32768, (const bf16_t*)(ws + WS_SMALL + 262144 + 131072) + (size_t)l * 32768, ws + WS_GSCR + ((size_t)c * 4 + 3) * 131072, c);
                flag_arrive_wt(cnt1);
                __syncthreads();
            }
            {
                __syncthreads();
                ArgsP ap = args_ptr(); unsigned char* ws = ap->ws; const int c = bid_(), G = gridDim.x;
                const bf16_t* PROJ = (const bf16_t*)(ws + WS_PROJ); bf16_t* Y01 = (bf16_t*)(ws + WS_Y);
                for (int u = c; u < 512; u += G) sb_unit(lds, PROJ, Y01, u & 3, tile_of(u));
                __syncthreads();
            }
            {
                ArgsP ap = args_ptr(); unsigned char* ws = ap->ws; const int c = bid_();
                float* AGG = (float*)(ws + WS_AGG); float* GAGG = AGG + 256 * 1024;
                unsigned* bar = (unsigned*)ws; unsigned* cnt1 = bar + 3584 + 64 * (l * 2 + b); unsigned* cnt2 = bar + 3584 + 64 * (4 + l * 2 + b);
                if (c < 16) {
                    flag_wait_nf(cnt1, 256u, bar);
                    const int ch = tid_(); float Pg = 1.f, Hg = 0.f; const float* ab = AGG + (size_t)c * 16 * 1024 + ch;
#pragma unroll
                    for (int i = 0; i < 16; ++i) { const float a = ld_agent(ab + i * 1024), bb = ld_agent(ab + i * 1024 + 512); Hg = a * Hg + bb; Pg *= a; }
                    __hip_atomic_store(GAGG + c * 1024 + ch, Pg, __ATOMIC_RELAXED, __HIP_MEMORY_SCOPE_AGENT); __hip_atomic_store(GAGG + c * 1024 + 512 + ch, Hg, __ATOMIC_RELAXED, __HIP_MEMORY_SCOPE_AGENT);
                    flag_arrive_wt(cnt2);
                }
            }
            {
                __syncthreads();
                ArgsP ap = args_ptr(); unsigned char* ws = ap->ws; const int c = bid_(), G = gridDim.x;
                const bf16_t* PROJ = (const bf16_t*)(ws + WS_PROJ); bf16_t* Y01 = (bf16_t*)(ws + WS_Y);
                const bf16_t* Wpool_t = (const bf16_t*)(ws + WS_SMALL); const float* psc = ap->pool_scale + l * 512;
                int gcur = -1;
                for (int u = c; u < 512; u += G) { const int g = u & 3;
                    if (g != gcur) { __syncthreads(); pool_stage(lds, Wpool_t + (size_t)(l * 4 + g) * 16384); __syncthreads(); gcur = g; }
                    pool_tile(lds, PROJ, Y01, psc, g, tile_of(u)); }
                __syncthreads();
            }
            {
                __syncthreads();
                ArgsP ap = args_ptr(); unsigned char* ws = ap->ws; const int c = bid_(), G = gridDim.x;
                const bf16_t* PROJ = (const bf16_t*)(ws + WS_PROJ); bf16_t* Y23 = (bf16_t*)(ws + WS_Y) + (size_t)16384 * 1024;
                const bf16_t* KVM = (const bf16_t*)(ws + WS_KVM) + (size_t)l * 512 * 1024 + (size_t)b * 256 * 1024;
                int hcur = -1;
                for (int u = c; u < 512; u += G) { const int h = u & 3;
                    if (h != hcur) { __syncthreads(); xa_stage(lds, KVM, h); __syncthreads(); hcur = h; }
                    xa_tile(lds, PROJ, Y23, h, u >> 2); }
            }
            {
                ArgsP ap = args_ptr(); unsigned char* ws = ap->ws; const int c = bid_();
                const bf16_t* PROJ = (const bf16_t*)(ws + WS_PROJ); bf16_t* Y23 = (bf16_t*)(ws + WS_Y) + (size_t)16384 * 1024;
                float* AGG = (float*)(ws + WS_AGG); float* GAGG = AGG + 256 * 1024;
                unsigned* bar = (unsigned*)ws; unsigned* cnt2 = bar + 3584 + 64 * (4 + l * 2 + b);
                __syncthreads();
                flag_wait_nf(cnt2, 16u, bar);
                lru_final(lds, PROJ, Y23, AGG, GAGG, ws + WS_GSCR + ((size_t)c * 4 + 3) * 131072, c);
            }
            {
                __syncthreads();
                ArgsP ap = args_ptr(); unsigned char* ws = ap->ws; const int c = bid_();
                SchedP3G S{(const char*)(ws + WS_XN) + (size_t)b * SEQ * DM * 2, (const char*)(ws + WS_WIN) + ((size_t)l * NIN + 5120) * DM * 2, c};
                EpiP3G E{ws + WS_GSCR + (size_t)c * 4 * 131072};
                pg8::gemm_phase<EpiP3G, SchedP3G, true>(lds, 2048, 2048, S, E);
            }
            GRID_BAR();
            {
                __syncthreads();
                ArgsP ap = args_ptr(); unsigned char* ws = ap->ws; const int c = bid_();
                SchedP3B S2{(const char*)(ws + WS_Y), (const char*)(ws + WS_WB) + (size_t)l * 4 * 1024 * 1024 * 2, c};
                EpiP3B E2{ws + WS_GSCR + (size_t)c * 4 * 131072, (bf16_t*)(ws + WS_GSCR + (size_t)c * 4 * 131072)};
                pg8::gemm_phase<EpiP3B, SchedP3B, true>(lds, 2048, 2048, S2, E2);
            }
            {
                ArgsP ap = args_ptr(); unsigned char* ws = ap->ws; const int c = bid_();
                const int pm = 8 * (c & 7) + ((c >> 3) >> 2);
                unsigned* bar = (unsigned*)ws; unsigned* cntA = bar + 4096 + (((l * 2 + b) * 2 + 0) * 64 + pm) * 16; unsigned* cntB = bar + 4096 + (((l * 2 + b) * 2 + 1) * 64 + pm) * 16;
                flag_arrive_wt(cntA);
                flag_wait(cntA, 4u, bar);
                const float* xres = (l == 0 ? ap->x : (const float*)ap->out) + (size_t)b * SEQ * DM;
                SchedP4 S{(const char*)(ws + WS_GSCR), (const char*)(ws + WS_WO) + (size_t)l * DM * DM * 2, c};
                EpiP4 E{xres, ap->out + (size_t)b * SEQ * DM, (l + 1 < NLAYER) ? (bf16_t*)(ws + WS_XN) + (size_t)b * SEQ * DM : (bf16_t*)nullptr, ap->ln_g + l * DM, ap->ln_b + l * DM,
                        (float*)(ws + WS_AGG + 1536 * 1024), cntB, bar};
                pg8::gemm_phase<EpiP4, SchedP4, true, true>(lds, 512, 2048, S, E);
            }
        }
    }
}

extern "C" void kernel_launch(void* const* d_in, const int* in_sizes, int n_in, void* d_out, int out_size, void* d_ws, size_t ws_size, hipStream_t stream) {
    static int ok = 0;
    if (ok == 0) {
        ok = 1;
        if (n_in != 17 || ws_size < WS_END) { fprintf(stderr, "kernel_launch: unexpected inputs (n_in %d, ws %zu)\n", n_in, ws_size); ok = -1; }
        if (hipFuncSetAttribute((const void*)mk_fwd, hipFuncAttributeMaxDynamicSharedMemorySize, LDS_BYTES) != hipSuccess) { fprintf(stderr, "kernel_launch: hipFuncSetAttribute failed\n"); ok = -1; }
        (void)hipGetLastError();
    }
    if (ok < 0) return;
    Args a{};
    a.x = (const float*)d_in[0]; a.mem = (const float*)d_in[1]; a.w_in = (const float*)d_in[2]; a.w_pool = (const float*)d_in[3]; a.pool_scale = (const float*)d_in[4];
    a.conv_w = (const float*)d_in[5]; a.conv_b = (const float*)d_in[6]; a.w_rg = (const float*)d_in[7]; a.b_rg = (const float*)d_in[8]; a.w_ig = (const float*)d_in[9];
    a.b_ig = (const float*)d_in[10]; a.lru_L = (const float*)d_in[11]; a.w_mem_kv = (const float*)d_in[12]; a.w_branch = (const float*)d_in[13]; a.w_out = (const float*)d_in[14];
    a.ln_g = (const float*)d_in[15]; a.ln_b = (const float*)d_in[16]; a.out = (float*)d_out; a.ws = (unsigned char*)d_ws;
    (void)hipMemsetAsync(d_ws, 0, 49152, stream);
    void* args[] = {&a};
    hipError_t e = hipLaunchCooperativeKernel((const void*)mk_fwd, dim3(256), dim3(512), args, LDS_BYTES, stream);
    if (e != hipSuccess) fprintf(stderr, "kernel_launch: cooperative launch failed: %s\n", hipGetErrorString(e));
}
```

```cpp
#include <hip/hip_runtime.h>
#include <hip/hip_cooperative_groups.h>
#include <cstdio>
#include <cstdint>
namespace cg = cooperative_groups;

#define LAS __attribute__((address_space(3)))
typedef unsigned short bf16_t;
typedef short bf16x8 __attribute__((ext_vector_type(8)));
typedef float f32x4 __attribute__((ext_vector_type(4)));
typedef unsigned u32x4 __attribute__((ext_vector_type(4)));
typedef unsigned u32x2 __attribute__((ext_vector_type(2)));

constexpr int DM = 1024, SEQ = 16384, NBATCH = 2, NIN = 9216, PW = 5120, MEMLEN = 256, NLAYER = 2;
constexpr float DN_ALPHA = 1.41421356237f, LN_EPS = 1e-5f;
constexpr size_t MiB = 1024 * 1024;
constexpr size_t WS_SMALL = 1 * MiB;
constexpr size_t WS_MEMB = 2 * MiB;
constexpr size_t WS_KVM = 3 * MiB;
constexpr size_t WS_AGG = 5 * MiB;
constexpr size_t WS_WIN = 8 * MiB;
constexpr size_t WS_WB = 44 * MiB;
constexpr size_t WS_WO = 60 * MiB;
constexpr size_t WS_WKV = 64 * MiB;
constexpr size_t WS_XN = 72 * MiB;
constexpr size_t WS_PROJ = 136 * MiB;
constexpr size_t WS_Y = 296 * MiB;
constexpr size_t WS_GSCR = 360 * MiB;
constexpr size_t WS_END = 488 * MiB;
constexpr int LDS_BYTES = 147456;
constexpr int LDS_BARW = 147456 - 64;

__device__ __forceinline__ unsigned cvt_pk_bf16(float lo, float hi) { unsigned r; asm volatile("v_cvt_pk_bf16_f32 %0, %1, %2" : "=v"(r) : "v"(lo), "v"(hi)); return r; }
__device__ __forceinline__ float bf_lo(unsigned u) { return __uint_as_float(u << 16); }
__device__ __forceinline__ float bf_hi(unsigned u) { return __uint_as_float(u & 0xffff0000u); }
__device__ __forceinline__ float bf1(bf16_t u) { return __uint_as_float(((unsigned)u) << 16); }
__device__ __forceinline__ float rcp_(float x) { return __builtin_amdgcn_rcpf(x); }
__device__ __forceinline__ float sigmoidf_(float x) { return rcp_(1.0f + __expf(-x)); }
__device__ __forceinline__ float siluf_(float x) { return x * rcp_(1.0f + __expf(-x)); }
__device__ __forceinline__ int tid_() { int t = threadIdx.x; asm volatile("" : "+v"(t)); return t; }
__device__ __forceinline__ int bid_() { int t = blockIdx.x; asm volatile("" : "+s"(t)); return t; }
__device__ __forceinline__ float bperm(int addr4, float v) { return __int_as_float(__builtin_amdgcn_ds_bpermute(addr4, __float_as_int(v))); }
typedef short s16x4 __attribute__((ext_vector_type(4)));
__device__ __forceinline__ u32x2 lds_tr16(const LAS bf16_t* p) { return __builtin_bit_cast(u32x2, __builtin_amdgcn_ds_read_tr16_b64_v4i16((LAS s16x4*)p)); }
__device__ __forceinline__ __amdgpu_buffer_rsrc_t mk_rsrc(const void* p) { return __builtin_amdgcn_make_buffer_rsrc((void*)p, 0, 0x7fffffff, 0x00020000); }
__device__ __forceinline__ void st_wt16(__amdgpu_buffer_rsrc_t rs, int byte_off, u32x4 v) { __builtin_amdgcn_raw_buffer_store_b128(v, rs, byte_off, 0, 16); }
__device__ __forceinline__ void st_wt8(__amdgpu_buffer_rsrc_t rs, int byte_off, u32x2 v) { __builtin_amdgcn_raw_buffer_store_b64(v, rs, byte_off, 0, 16); }
__device__ __forceinline__ int tile_of(int u) { return ((((u & 7) >> 2) * 2 + (u >> 8)) * 32) + ((u & 255) >> 3); }
__device__ __forceinline__ void store_row_tiles(const __amdgpu_buffer_rsrc_t rs, const int base_byte, const u32x2 (&r)[8], const int lane, const int quad) {
    const bool odd = (quad & 1) != 0; const int pa = (lane ^ 16) << 2;
#pragma unroll
    for (int tp = 0; tp < 4; ++tp) {
        const u32x2 mine0 = r[2 * tp], mine1 = r[2 * tp + 1];
        const u32x2 snd = odd ? mine0 : mine1; u32x2 rcv;
        rcv.x = (unsigned)__builtin_amdgcn_ds_bpermute(pa, (int)snd.x); rcv.y = (unsigned)__builtin_amdgcn_ds_bpermute(pa, (int)snd.y);
        const u32x4 o = odd ? (u32x4){rcv.x, rcv.y, mine1.x, mine1.y} : (u32x4){mine0.x, mine0.y, rcv.x, rcv.y};
        const int d = odd ? (2 * tp + 1) * 16 + (quad - 1) * 4 : (2 * tp) * 16 + quad * 4;
        __builtin_amdgcn_raw_buffer_store_b128(o, rs, base_byte + d * 2, 0, 0); }
}
#define LDS_WAIT() asm volatile("s_waitcnt lgkmcnt(0)" ::: "memory")

__device__ __forceinline__ void flag_arrive(unsigned* cnt);
__device__ __forceinline__ void flag_arrive_wt(unsigned* cnt);
__device__ __forceinline__ void flag_wait_nf(unsigned* cnt, unsigned target, unsigned* bar);
__device__ __forceinline__ void flag_wait(unsigned* cnt, unsigned target, unsigned* bar);
namespace pg8 {
constexpr int BM = 256, BK = 64, HALF = 128, HTB = HALF * BK * 2;
__device__ __forceinline__ int lds_byte(int r, int c) { const int st = (r >> 4) * 2 + (c >> 5), rr = r & 15, cc = c & 31, ob = rr * 64 + cc * 2; return st * 1024 + (ob ^ (((ob >> 9) & 1) << 5)); }
__device__ __forceinline__ void stage_rc(int b, int& R, int& C) { const int st = b / 1024, sb = b % 1024, swz = sb ^ (((sb >> 9) & 1) << 5); R = (st >> 1) * 16 + swz / 64; C = (st & 1) * 32 + (swz % 64) / 2; }
__device__ __forceinline__ int perm32(int rho) { const int n = rho >> 4, i = rho & 15; return 8 * (i >> 2) + 4 * n + (i & 3); }

struct UD { const char* A; const char* B; int nt, kind, pm, pn, aux; };

template <class Epi, class Sched, bool ALIGN_EPI, bool AFTER_DRAIN = false>
__device__ __forceinline__ void gemm_phase(LAS unsigned char* lds, const int lda2, const int ldb2, const Sched& S, const Epi& E) {
    const int tid = tid_(), wid = __builtin_amdgcn_readfirstlane(tid >> 6), lane = tid & 63, wr = wid >> 2, wc = wid & 3, fr = lane & 15, fq = lane >> 4;
    unsigned voffA[2], voffB[2];
#pragma unroll
    for (int i = 0; i < 2; ++i) { int R, C; stage_rc(tid * 16 + i * 8192, R, C); const int Rb = Epi::PERM ? ((R & ~31) + perm32(R & 31)) : R;
        voffA[i] = (unsigned)(R * lda2 + C * 2); voffB[i] = (unsigned)(Rb * ldb2 + C * 2); }
    const size_t kstep = (size_t)(BK * 2);
    const size_t hA = (size_t)HALF * lda2, hB = (size_t)HALF * ldb2;
    const unsigned ldsw = (unsigned)wid * 1024u;
    const int aoff = lds_byte(wr * 64 + fr, fq * 8), boff = lds_byte(wc * 32 + fr, fq * 8);
#define PG8_SA(b, h) (((b) * 2 + (h)) * HTB)
#define PG8_SB(b, h) ((4 + (b) * 2 + (h)) * HTB)
#define PG8_STAGE(bufoff, gbase, voff) do { _Pragma("unroll") for (int _i = 0; _i < 2; ++_i) \
        __builtin_amdgcn_global_load_lds((const unsigned*)((const char*)(gbase) + (voff)[_i]), (LAS unsigned*)(lds + (bufoff) + ldsw + _i * 8192), 16, 0, 0); } while (0)
#define PG8_LDA(dst, b, h) do { _Pragma("unroll") for (int m = 0; m < 4; ++m) _Pragma("unroll") for (int k = 0; k < 2; ++k) dst[m][k] = *(const LAS bf16x8*)(lds + PG8_SA(b, h) + aoff + m * 2048 + k * 1024); } while (0)
#define PG8_LDB(dst, b, h) do { _Pragma("unroll") for (int n = 0; n < 2; ++n) _Pragma("unroll") for (int k = 0; k < 2; ++k) dst[n][k] = *(const LAS bf16x8*)(lds + PG8_SB(b, h) + boff + n * 2048 + k * 1024); } while (0)
#define PG8_MMA(ai, bj, At, Bt) do { __builtin_amdgcn_s_setprio(1); _Pragma("unroll") for (int m = 0; m < 4; ++m) _Pragma("unroll") for (int n = 0; n < 2; ++n) _Pragma("unroll") for (int k = 0; k < 2; ++k) \
        acc[ai][bj][m][n] = __builtin_amdgcn_mfma_f32_16x16x32_bf16(Bt[n][k], At[m][k], acc[ai][bj][m][n], 0, 0, 0); __builtin_amdgcn_s_setprio(0); } while (0)
#define PG8_WAIT_V(n) asm volatile("s_waitcnt vmcnt(" #n ")" ::: "memory")
#define PG8_WAIT_L(n) asm volatile("s_waitcnt lgkmcnt(" #n ")" ::: "memory")
#define PG8_BAR __builtin_amdgcn_s_barrier()
#define PG8_SCHED __builtin_amdgcn_sched_barrier(0)
    UD cur, nxt; int ui = 0;
    if (!S.next(0, cur)) return;
    f32x4 acc[2][2][4][2];
#pragma unroll
    for (int a = 0; a < 2; ++a)
#pragma unroll
        for (int b = 0; b < 2; ++b)
#pragma unroll
            for (int m = 0; m < 4; ++m)
#pragma unroll
                for (int n = 0; n < 2; ++n) acc[a][b][m][n] = (f32x4){0.f, 0.f, 0.f, 0.f};
    bf16x8 At[4][2], B0[2][2], B1[2][2];
    const char* cA = cur.A; const char* cB = cur.B;
    PG8_STAGE(PG8_SB(0, 0), cB, voffB); PG8_STAGE(PG8_SB(0, 1), cB + hB, voffB); PG8_STAGE(PG8_SA(0, 0), cA, voffA); PG8_STAGE(PG8_SA(0, 1), cA + hA, voffA);
    if (wr == 1) PG8_BAR;
    PG8_WAIT_V(2); PG8_BAR;
    PG8_STAGE(PG8_SB(1, 0), cB + kstep, voffB); PG8_STAGE(PG8_SA(1, 0), cA + kstep, voffA); PG8_STAGE(PG8_SB(1, 1), cB + hB + kstep, voffB);
    PG8_WAIT_V(6); PG8_BAR;
    for (;;) {
        const bool has_next = S.next(ui + 1, nxt);
        const char* nA = has_next ? nxt.A : cA; const char* nB = has_next ? nxt.B : cB;
        const int nt = cur.nt;
        for (int t = 0; t < nt; t += 2) {
            const bool last = (t == nt - 2);
            const char* a1 = cA + (size_t)(t + 1) * kstep;
            const char* a2 = last ? nA : cA + (size_t)(t + 2) * kstep; const char* b2 = last ? nB : cB + (size_t)(t + 2) * kstep;
            const char* a3 = a2 + kstep; const char* b3 = b2 + kstep;
            PG8_LDB(B0, 0, 0); PG8_LDB(B1, 0, 1); PG8_SCHED; PG8_LDA(At, 0, 0); PG8_STAGE(PG8_SA(1, 1), a1 + hA, voffA);
            PG8_WAIT_V(8); PG8_WAIT_L(0); PG8_BAR; PG8_MMA(0, 0, At, B0); PG8_MMA(0, 1, At, B1); PG8_BAR; PG8_SCHED;
            PG8_LDA(At, 0, 1); PG8_STAGE(PG8_SB(0, 0), b2, voffB); PG8_STAGE(PG8_SB(0, 1), b2 + hB, voffB); PG8_STAGE(PG8_SA(0, 0), a2, voffA);
            PG8_WAIT_V(8); PG8_WAIT_L(0); PG8_BAR; PG8_MMA(1, 0, At, B0); PG8_MMA(1, 1, At, B1); PG8_BAR; PG8_SCHED;
            PG8_LDB(B0, 1, 0); PG8_LDB(B1, 1, 1); PG8_SCHED; PG8_LDA(At, 1, 0); PG8_STAGE(PG8_SA(0, 1), a2 + hA, voffA);
            PG8_WAIT_V(8); PG8_WAIT_L(0); PG8_BAR; PG8_MMA(0, 0, At, B0); PG8_MMA(0, 1, At, B1); PG8_BAR; PG8_SCHED;
            PG8_LDA(At, 1, 1); PG8_STAGE(PG8_SB(1, 0), b3, voffB); PG8_STAGE(PG8_SB(1, 1), b3 + hB, voffB); PG8_STAGE(PG8_SA(1, 0), a3, voffA);
            PG8_WAIT_V(8); PG8_WAIT_L(0); PG8_BAR; PG8_MMA(1, 0, At, B0); PG8_MMA(1, 1, At, B1); PG8_BAR; PG8_SCHED;
        }
        if constexpr (ALIGN_EPI) { if (wr == 0) PG8_BAR; }
        bool zero = false;
        if (!AFTER_DRAIN || has_next) zero = E(acc, cur, wr, wc, fr, fq);
        if (!has_next) break;
        if (zero) {
#pragma unroll
            for (int a = 0; a < 2; ++a)
#pragma unroll
                for (int b = 0; b < 2; ++b)
#pragma unroll
                    for (int m = 0; m < 4; ++m)
#pragma unroll
                        for (int n = 0; n < 2; ++n) acc[a][b][m][n] = (f32x4){0.f, 0.f, 0.f, 0.f};
        }
        cur = nxt; cA = nA; cB = nB; ++ui;
        if constexpr (ALIGN_EPI) { if (wr == 1) PG8_BAR; }
    }
    PG8_WAIT_V(0);
    if constexpr (!ALIGN_EPI) { if (wr == 0) PG8_BAR; }
    PG8_BAR;
    if constexpr (AFTER_DRAIN) E.fused(acc, cur, wr, wc, fr, fq, lds);
#undef PG8_SA
#undef PG8_SB
#undef PG8_STAGE
#undef PG8_LDA
#undef PG8_LDB
#undef PG8_MMA
#undef PG8_WAIT_V
#undef PG8_WAIT_L
#undef PG8_BAR
#undef PG8_SCHED
}
}
using pg8::UD;

struct EpiP1 {
    static constexpr bool PERM = true;
    bf16_t* O; int ldc;
    __device__ __forceinline__ bool operator()(const f32x4 (&acc)[2][2][4][2], const UD& u, int wr, int wc, int fr, int fq) const {
        const int row0 = u.pm * 256 + wr * 64 + fr, col0 = u.pn * 256 + wc * 32 + 8 * fq;
        const __amdgpu_buffer_rsrc_t rs = __builtin_amdgcn_make_buffer_rsrc((void*)O, 0, 0x7fffffff, 0x00020000);
        const int voff = (row0 * ldc + col0) * 2;
#pragma unroll
        for (int ai = 0; ai < 2; ++ai)
#pragma unroll
            for (int m = 0; m < 4; ++m) {
#pragma unroll
                for (int bj = 0; bj < 2; ++bj) { const f32x4 v0 = acc[ai][bj][m][0], v1 = acc[ai][bj][m][1]; u32x4 w;
                    w.x = cvt_pk_bf16(v0[0], v0[1]); w.y = cvt_pk_bf16(v0[2], v0[3]); w.z = cvt_pk_bf16(v1[0], v1[1]); w.w = cvt_pk_bf16(v1[2], v1[3]);
                    __builtin_amdgcn_raw_buffer_store_b128(w, rs, voff, ((ai * 128 + m * 16) * ldc + bj * 128) * 2, 16); } }
        return true;
    }
};
struct SchedP1 {
    const char* A; const char* W; int c;
    __device__ __forceinline__ bool next(int i, UD& u) const {
        if (i >= 5) return false;
        const int xcd = c & 7, j = c >> 3, idx = i * 32 + j, pn = idx >> 3, pm = xcd * 8 + (idx & 7);
        u.A = A + (size_t)pm * 256 * 2048; u.B = W + (size_t)pn * 256 * 2048; u.nt = 16; u.kind = 0; u.pm = pm; u.pn = pn; u.aux = 0; return true;
    }
};
struct SchedKV {
    const char* memb; const char* wkv; int c;
    __device__ __forceinline__ bool next(int i, UD& u) const {
        if (i >= 1 || c >= 16) return false;
        const int lay = c >> 3, pm = (c & 7) >> 2, pn = c & 3;
        u.A = memb + (size_t)pm * 256 * 2048; u.B = wkv + (size_t)lay * 2 * MiB + (size_t)pn * 256 * 2048; u.nt = 16; u.kind = 1; u.pm = pm; u.pn = pn; u.aux = lay; return true;
    }
};
struct EpiP3G {
    static constexpr bool PERM = true;
    unsigned char* gs;
    __device__ __forceinline__ bool operator()(const f32x4 (&acc)[2][2][4][2], const UD& u, int wr, int wc, int fr, int fq) const {
        unsigned char* t = gs + (size_t)u.aux * 131072; const unsigned lo16 = (unsigned)tid_() * 16u;
#pragma unroll
        for (int ai = 0; ai < 2; ++ai)
#pragma unroll
            for (int bj = 0; bj < 2; ++bj)
#pragma unroll
                for (int m = 0; m < 4; ++m) { const int ci = (ai * 2 + bj) * 4 + m; float g[8];
#pragma unroll
                    for (int e = 0; e < 8; ++e) g[e] = fminf(1.0f + __expf(-acc[ai][bj][m][e >> 2][e & 3]), 1e9f);
                    u32x4 w; w.x = cvt_pk_bf16(g[0], g[1]); w.y = cvt_pk_bf16(g[2], g[3]); w.z = cvt_pk_bf16(g[4], g[5]); w.w = cvt_pk_bf16(g[6], g[7]);
                    *(u32x4*)(t + ci * 8192 + lo16) = w; }
        return true;
    }
};
struct SchedP3G {
    const char* xn; const char* wg; int c;
    __device__ __forceinline__ bool next(int i, UD& u) const {
        if (i >= 4) return false;
        const int pm = 8 * (c & 7) + ((c >> 3) >> 2), pn = (c >> 3) & 3; u.pm = pm; u.pn = pn;
        u.A = xn + (size_t)pm * 256 * 2048; u.B = wg + (size_t)(i * 1024 + pn * 256) * 2048; u.nt = 16; u.kind = 2; u.aux = i; return true;
    }
};
struct EpiP3B {
    static constexpr bool PERM = true;
    unsigned char* gs; bf16_t* merged;
    __device__ __forceinline__ bool operator()(f32x4 (&acc)[2][2][4][2], const UD& u, int wr, int wc, int fr, int fq) const {
        const int n = u.aux; const bool fin = (n == 3);
        const __amdgpu_buffer_rsrc_t rs = __builtin_amdgcn_make_buffer_rsrc((void*)gs, 0, 0x7fffffff, 0x00020000);
        const int s0 = n * 131072, s1 = (fin ? 3 : n + 1) * 131072; const int lo16 = (int)tid_() * 16;
#pragma unroll
        for (int ai = 0; ai < 2; ++ai)
#pragma unroll
            for (int bj = 0; bj < 2; ++bj)
#pragma unroll
                for (int m = 0; m < 4; ++m) { const int ci = (ai * 2 + bj) * 4 + m;
                    const u32x4 ga = __builtin_amdgcn_raw_buffer_load_b128(rs, lo16, s0 + ci * 8192, 0);
                    u32x4 gb = __builtin_amdgcn_raw_buffer_load_b128(rs, lo16, s1 + ci * 8192, 0);
                    if (fin) gb = (u32x4){0x3f803f80u, 0x3f803f80u, 0x3f803f80u, 0x3f803f80u};
                    f32x4 v0 = acc[ai][bj][m][0], v1 = acc[ai][bj][m][1];
                    v0[0] *= bf_lo(gb.x) * rcp_(bf_lo(ga.x)); v0[1] *= bf_hi(gb.x) * rcp_(bf_hi(ga.x));
                    v0[2] *= bf_lo(gb.y) * rcp_(bf_lo(ga.y)); v0[3] *= bf_hi(gb.y) * rcp_(bf_hi(ga.y));
                    v1[0] *= bf_lo(gb.z) * rcp_(bf_lo(ga.z)); v1[1] *= bf_hi(gb.z) * rcp_(bf_hi(ga.z));
                    v1[2] *= bf_lo(gb.w) * rcp_(bf_lo(ga.w)); v1[3] *= bf_hi(gb.w) * rcp_(bf_hi(ga.w));
                    acc[ai][bj][m][0] = v0; acc[ai][bj][m][1] = v1; }
        if (!fin) return false;
        const int row0 = wr * 64 + fr, col0 = wc * 32 + 8 * fq;
#pragma unroll
        for (int ai = 0; ai < 2; ++ai)
#pragma unroll
            for (int m = 0; m < 4; ++m) {
#pragma unroll
                for (int bj = 0; bj < 2; ++bj) { const f32x4 v0 = acc[ai][bj][m][0], v1 = acc[ai][bj][m][1]; u32x4 w;
                    w.x = cvt_pk_bf16(v0[0], v0[1]); w.y = cvt_pk_bf16(v0[2], v0[3]); w.z = cvt_pk_bf16(v1[0], v1[1]); w.w = cvt_pk_bf16(v1[2], v1[3]);
                    __builtin_amdgcn_raw_buffer_store_b128(w, rs, (row0 * 256 + col0) * 2, ((ai * 128 + m * 16) * 256 + bj * 128) * 2, 16); } }
        return true;
    }
};
struct SchedP3B {
    const char* y; const char* wb; int c;
    __device__ __forceinline__ bool next(int i, UD& u) const {
        if (i >= 4) return false;
        const int pm = 8 * (c & 7) + ((c >> 3) >> 2), pn = (c >> 3) & 3; u.pm = pm; u.pn = pn;
        u.A = y + (size_t)(i >> 1) * 32 * MiB + (size_t)pm * 256 * 2048 + (size_t)(i & 1) * 1024; u.B = wb + (size_t)i * 2 * MiB + (size_t)pn * 256 * 2048; u.nt = 8; u.kind = 3; u.aux = i; return true;
    }
};
struct EpiP4 {
    static constexpr bool PERM = false;
    const float* xres; float* out; bf16_t* xn; const float* gam; const float* bet; float* stats; unsigned* cnt; unsigned* bar;
    __device__ __forceinline__ bool operator()(const f32x4 (&acc)[2][2][4][2], const UD& u, int wr, int wc, int fr, int fq) const { return false; }
    __device__ __forceinline__ void fused(f32x4 (&acc)[2][2][4][2], const UD& u, int wr, int wc, int fr, int fq, LAS unsigned char* lds) const {
        const int tid = tid_(), lane = tid & 63;
        LAS float* PS = (LAS float*)lds;
        LAS float* RS = (LAS float*)(lds + 8192);
        const int row0 = u.pm * 256 + wr * 64 + fr, col0 = u.pn * 256 + wc * 32 + 4 * fq;
#pragma unroll
        for (int ai = 0; ai < 2; ++ai)
#pragma unroll
            for (int m = 0; m < 4; ++m) { const unsigned off = (unsigned)((row0 + ai * 128 + m * 16) * DM + col0); float sm = 0.f, sq = 0.f;
#pragma unroll
                for (int bj = 0; bj < 2; ++bj)
#pragma unroll
                    for (int n = 0; n < 2; ++n) { const f32x4 xv = *(const f32x4*)(xres + (off + (unsigned)(bj * 128 + n * 16)));
                        const f32x4 v = xv * DN_ALPHA + acc[ai][bj][m][n]; acc[ai][bj][m][n] = v;
                        sm += (v[0] + v[1]) + (v[2] + v[3]); sq += (v[0] * v[0] + v[1] * v[1]) + (v[2] * v[2] + v[3] * v[3]); }
                sm += bperm((lane ^ 16) << 2, sm); sm += bperm((lane ^ 32) << 2, sm); sq += bperm((lane ^ 16) << 2, sq); sq += bperm((lane ^ 32) << 2, sq);
                if (fq == 0) { const int rl = ai * 128 + wr * 64 + m * 16 + fr; PS[(rl * 4 + wc) * 2] = sm; PS[(rl * 4 + wc) * 2 + 1] = sq; }
                if (m & 1) asm volatile("" ::: "memory"); }
        __syncthreads();
        if (tid < 256) { const f32x4 p0 = *(const LAS f32x4*)(PS + tid * 8), p1 = *(const LAS f32x4*)(PS + tid * 8 + 4);
            float* st = stats + ((size_t)(u.pm * 256 + tid) * 4 + u.pn) * 2; const float s_ = (p0[0] + p0[2]) + (p1[0] + p1[2]), q_ = (p0[1] + p0[3]) + (p1[1] + p1[3]);
            __hip_atomic_store((unsigned long long*)st, ((unsigned long long)__float_as_uint(q_) << 32) | __float_as_uint(s_), __ATOMIC_RELAXED, __HIP_MEMORY_SCOPE_AGENT); }
        flag_arrive_wt(cnt);
        flag_wait_nf(cnt, 4u, bar);
        if (tid < 256) { const unsigned long long* st = (const unsigned long long*)(stats + (size_t)(u.pm * 256 + tid) * 8);
            float ssum = 0.f, qsum = 0.f;
#pragma unroll
            for (int k = 0; k < 4; ++k) { const unsigned long long w_ = __hip_atomic_load(st + k, __ATOMIC_RELAXED, __HIP_MEMORY_SCOPE_AGENT); ssum += __uint_as_float((unsigned)w_); qsum += __uint_as_float((unsigned)(w_ >> 32)); }
            const float mean = ssum * (1.0f / DM); const float var = qsum * (1.0f / DM) - mean * mean;
            RS[tid * 2] = mean; RS[tid * 2 + 1] = 1.0f / sqrtf(fmaxf(var, 0.f) + LN_EPS); }
        __syncthreads();
#pragma unroll
        for (int bj = 0; bj < 2; ++bj)
#pragma unroll
            for (int n = 0; n < 2; ++n) { const int cc = col0 + bj * 128 + n * 16; const f32x4 gv = *(const f32x4*)(gam + cc), bv = *(const f32x4*)(bet + cc);
#pragma unroll
                for (int ai = 0; ai < 2; ++ai)
#pragma unroll
                    for (int m = 0; m < 4; ++m) { const int rl = ai * 128 + wr * 64 + m * 16 + fr; const float mean = RS[rl * 2], rstd = RS[rl * 2 + 1];
                        const unsigned off = (unsigned)((u.pm * 256 + rl) * DM + cc);
                        const f32x4 y = (acc[ai][bj][m][n] - mean) * rstd * gv + bv; st_wt16(mk_rsrc(out), (int)(off * 4u), __builtin_bit_cast(u32x4, y));
                        if (xn) { u32x2 pk; pk.x = cvt_pk_bf16(y[0], y[1]); pk.y = cvt_pk_bf16(y[2], y[3]); st_wt8(mk_rsrc(xn), (int)(off * 2u), pk); } } }
    }
};
struct SchedP4 {
    const char* gscr; const char* wo; int c;
    __device__ __forceinline__ bool next(int i, UD& u) const {
        if (i >= 4) return false;
        const int pm = 8 * (c & 7) + ((c >> 3) >> 2), pn = (c >> 3) & 3; u.pm = pm; u.pn = pn;
        const int owner = (pm >> 3) + 8 * (((pm & 7) << 2) + i);
        u.A = gscr + (size_t)owner * 4 * 131072; u.B = wo + (size_t)pn * 256 * 2048 + (size_t)i * 512; u.nt = 4; u.kind = 4; u.aux = i; return true;
    }
};

__device__ __forceinline__ unsigned f2bf(float f) { unsigned u = __builtin_bit_cast(unsigned, f); return (u + 0x7fffu + ((u >> 16) & 1u)) >> 16; }
__device__ __forceinline__ unsigned pk2(float lo, float hi) { return f2bf(lo) | (f2bf(hi) << 16); }
struct TItem { const float* W; bf16_t* WT; int N, pitch, item; };
__device__ __forceinline__ void tr_load(const TItem& t, const int lane, f32x4 (&tv)[8]) {
    const int nblk = t.N / 32, kb = t.item / nblk, nb = t.item % nblk, k0 = 64 * kb, n0 = 32 * nb, r8 = lane >> 3, q4 = (lane & 7) * 4;
#pragma unroll
    for (int i = 0; i < 8; ++i) tv[i] = *(const f32x4*)(t.W + (size_t)(k0 + 8 * i + r8) * t.N + n0 + q4);
}
__device__ __forceinline__ void tr_finish(const TItem& t, const int lane, const f32x4 (&tv)[8], LAS float* scr) {
    const int nblk = t.N / 32, kb = t.item / nblk, nb = t.item % nblk, k0 = 64 * kb, n0 = 32 * nb, r8 = lane >> 3, q4 = (lane & 7) * 4;
#pragma unroll
    for (int i = 0; i < 8; ++i) { LAS float* d = scr + (8 * i + r8) * 33 + q4; d[0] = tv[i][0]; d[1] = tv[i][1]; d[2] = tv[i][2]; d[3] = tv[i][3]; }
    LDS_WAIT();
    const int c = lane & 7;
#pragma unroll
    for (int j = 0; j < 4; ++j) { const int n = (lane >> 3) + 8 * j; const LAS float* sp = scr + (8 * c) * 33 + n;
        u32x4 o; o.x = pk2(sp[0 * 33], sp[1 * 33]); o.y = pk2(sp[2 * 33], sp[3 * 33]); o.z = pk2(sp[4 * 33], sp[5 * 33]); o.w = pk2(sp[6 * 33], sp[7 * 33]);
        *(u32x4*)(t.WT + (size_t)(n0 + n) * t.pitch + k0 + 8 * c) = o; }
    LDS_WAIT();
}

struct Args {
    const float* x; const float* mem; const float* w_in; const float* w_pool; const float* pool_scale; const float* conv_w; const float* conv_b;
    const float* w_rg; const float* b_rg; const float* w_ig; const float* b_ig; const float* lru_L; const float* w_mem_kv; const float* w_branch;
    const float* w_out; const float* ln_g; const float* ln_b; float* out; unsigned char* ws;
};

__device__ __forceinline__ void sb_unit(LAS unsigned char* lds, const bf16_t* __restrict__ P, bf16_t* __restrict__ Y01, const int h, const int i) {
    const int tid = tid_(), lane = tid & 63, w = __builtin_amdgcn_readfirstlane(tid >> 6), ql = lane & 15, quad = lane >> 4;
    LAS bf16_t* Ks = (LAS bf16_t*)lds;
    LAS bf16_t* Vs = Ks + 128 * 136;
    const LAS bf16_t* vtr = Vs + (quad * 4 + (ql >> 2)) * 144 + 4 * (ql & 3);
    const int qloc = w * 16 + ql; const size_t qrow = (size_t)i * 128 + qloc;
    const float scale2 = 0.08838834764831845f * 1.4426950408889634f;
    bf16x8 qf[4];
#pragma unroll
    for (int ks = 0; ks < 4; ++ks) qf[ks] = *(const bf16x8*)(P + qrow * PW + h * 128 + ks * 32 + quad * 8);
    f32x4 o[8]; u32x2 gq[8];
#pragma unroll
    for (int d = 0; d < 8; ++d) { o[d] = (f32x4){0.f, 0.f, 0.f, 0.f}; gq[d] = *(const u32x2*)(P + qrow * PW + 1536 + h * 128 + d * 16 + quad * 4); }
    float later = 0.f; int wdone = 0;
    u32x4 kreg[4], vreg[4];
#define SB_LOAD(JJ) do { _Pragma("unroll") for (int q_ = 0; q_ < 4; ++q_) { const int c_ = tid + q_ * 512, r_ = c_ >> 4, cc_ = c_ & 15; \
            const bf16_t* kp_ = P + ((size_t)(JJ) * 128 + r_) * PW + 512 + h * 128 + cc_ * 8; kreg[q_] = *(const u32x4*)kp_; vreg[q_] = *(const u32x4*)(kp_ + 512); } } while (0)
    SB_LOAD(i);
    __syncthreads();
    for (int j = i; ; --j) {
#pragma unroll
        for (int q = 0; q < 4; ++q) { const int c = tid + q * 512, r = c >> 4, cc = c & 15; *(LAS u32x4*)(Ks + r * 136 + cc * 8) = kreg[q]; *(LAS u32x4*)(Vs + r * 144 + cc * 8) = vreg[q]; }
        __syncthreads();
        if (j > 0) SB_LOAD(j - 1);
        if (!wdone) {
            const bool diag = (j == i);
            float R = later;
#pragma unroll
            for (int p = 3; p >= 0; --p) {
                if (!wdone && !(diag && 2 * p > w)) {
                    f32x4 s0 = (f32x4){0.f, 0.f, 0.f, 0.f}, s1 = (f32x4){0.f, 0.f, 0.f, 0.f};
#pragma unroll
                    for (int ks = 0; ks < 4; ++ks) {
                        const bf16x8 a0 = *(const LAS bf16x8*)(Ks + ((2 * p) * 16 + ql) * 136 + ks * 32 + quad * 8);
                        const bf16x8 a1 = *(const LAS bf16x8*)(Ks + ((2 * p + 1) * 16 + ql) * 136 + ks * 32 + quad * 8);
                        s0 = __builtin_amdgcn_mfma_f32_16x16x32_bf16(a0, qf[ks], s0, 0, 0, 0); s1 = __builtin_amdgcn_mfma_f32_16x16x32_bf16(a1, qf[ks], s1, 0, 0, 0); }
                    unsigned pw[4];
#pragma unroll
                    for (int hh = 1; hh >= 0; --hh) { const int kt = 2 * p + hh; const f32x4 sv = hh ? s1 : s0;
                        float l1[4], ls[4]; bool vd[4];
#pragma unroll
                        for (int e = 0; e < 4; ++e) { const float z = sv[e] * scale2; const float t = __builtin_amdgcn_logf(1.0f + __builtin_amdgcn_exp2f(-fabsf(z)));
                            vd[e] = !diag || (kt * 16 + quad * 4 + e < qloc);
                            const float nsp = -(fmaxf(z, 0.f) + t);
                            l1[e] = vd[e] ? nsp : 0.f; ls[e] = z + nsp; }
                        const float sl = (l1[0] + l1[1]) + (l1[2] + l1[3]);
                        const float x1 = bperm((lane ^ 16) << 2, sl); const float s1 = sl + x1;
                        const float y = bperm((lane ^ 32) << 2, s1);
                        const float gt = (((quad & 1) == 0) ? x1 : 0.f) + (((quad & 2) == 0) ? y : 0.f);
                        const float T = s1 + y;
                        const float w3 = R + gt, w2 = w3 + l1[3], w1 = w2 + l1[2], w0 = w1 + l1[1];
                        const float p0 = vd[0] ? __builtin_amdgcn_exp2f(ls[0] + w0) : 0.f, p1 = vd[1] ? __builtin_amdgcn_exp2f(ls[1] + w1) : 0.f;
                        const float p2 = vd[2] ? __builtin_amdgcn_exp2f(ls[2] + w2) : 0.f, p3 = vd[3] ? __builtin_amdgcn_exp2f(ls[3] + w3) : 0.f;
                        pw[hh * 2] = cvt_pk_bf16(p0, p1); pw[hh * 2 + 1] = cvt_pk_bf16(p2, p3);
                        R += T; }
                    const u32x4 pv = (u32x4){pw[0], pw[1], pw[2], pw[3]};
#pragma unroll
                    for (int dt = 0; dt < 8; ++dt) {
                        const u32x2 lo = lds_tr16(vtr + (2 * p) * 16 * 144 + dt * 16);
                        const u32x2 hi = lds_tr16(vtr + (2 * p + 1) * 16 * 144 + dt * 16);
                        const u32x4 av = (u32x4){lo.x, lo.y, hi.x, hi.y};
                        o[dt] = __builtin_amdgcn_mfma_f32_16x16x32_bf16(__builtin_bit_cast(bf16x8, av), __builtin_bit_cast(bf16x8, pv), o[dt], 0, 0, 0); }
                    wdone = __all(R < -150.05f) ? 1 : 0;
                }
            }
            later = R;
        }
        if (__syncthreads_and(wdone) || j == 0) break;
    }
    u32x2 rr[8];
#pragma unroll
    for (int dt = 0; dt < 8; ++dt) { const u32x2 g = gq[dt];
        rr[dt].x = cvt_pk_bf16(o[dt][0] * siluf_(bf_lo(g.x)), o[dt][1] * siluf_(bf_hi(g.x))); rr[dt].y = cvt_pk_bf16(o[dt][2] * siluf_(bf_lo(g.y)), o[dt][3] * siluf_(bf_hi(g.y))); }
    store_row_tiles(mk_rsrc(Y01), (int)((qrow * 1024 + h * 128) * 2), rr, lane, quad);
}

__device__ __forceinline__ void xa_stage(LAS unsigned char* lds, const bf16_t* __restrict__ KV  , const int h) {
    const int tid = tid_();
    LAS bf16_t* Kms = (LAS bf16_t*)lds;
    LAS bf16_t* Vm = Kms + 256 * 136;
    for (int c = tid; c < 4096; c += 512) { const int r = c >> 4, cc = c & 15;
        const bf16_t* kp = KV + (size_t)r * 1024 + h * 128 + cc * 8;
        *(LAS u32x4*)(Kms + r * 136 + cc * 8) = *(const u32x4*)kp; *(LAS u32x4*)(Vm + r * 144 + cc * 8) = *(const u32x4*)(kp + 512); }
}
__device__ __forceinline__ void xa_tile(LAS unsigned char* lds, const bf16_t* __restrict__ P, bf16_t* __restrict__ Y23, const int h, const int tile) {
    const int tid = tid_(), lane = tid & 63, w = tid >> 6, ql = lane & 15, quad = lane >> 4;
    const LAS bf16_t* Kms = (const LAS bf16_t*)lds;
    const LAS bf16_t* vtr = Kms + 256 * 136 + (quad * 4 + (ql >> 2)) * 144 + 4 * (ql & 3);
    const size_t qrow = (size_t)tile * 128 + w * 16 + ql;
    const float scale = 0.08838834764831845f;
    bf16x8 qf[4];
#pragma unroll
    for (int ks = 0; ks < 4; ++ks) qf[ks] = *(const bf16x8*)(P + qrow * PW + 4096 + h * 128 + ks * 32 + quad * 8);
    f32x4 s[16];
#pragma unroll
    for (int kt = 0; kt < 16; ++kt) { s[kt] = (f32x4){0.f, 0.f, 0.f, 0.f};
#pragma unroll
        for (int ks = 0; ks < 4; ++ks) { const bf16x8 a = *(const LAS bf16x8*)(Kms + (kt * 16 + ql) * 136 + ks * 32 + quad * 8);
            s[kt] = __builtin_amdgcn_mfma_f32_16x16x32_bf16(a, qf[ks], s[kt], 0, 0, 0); } }
    float m = -3.0e38f;
#pragma unroll
    for (int kt = 0; kt < 16; ++kt)
#pragma unroll
        for (int e = 0; e < 4; ++e) m = fmaxf(m, s[kt][e]);
    m = fmaxf(m, bperm((lane ^ (16)) << 2, m)); m = fmaxf(m, bperm((lane ^ (32)) << 2, m));
    float sum = 0.f; unsigned pw[32];
#pragma unroll
    for (int kt = 0; kt < 16; ++kt) { float p[4];
#pragma unroll
        for (int e = 0; e < 4; ++e) { p[e] = __builtin_amdgcn_exp2f((s[kt][e] - m) * (scale * 1.4426950408889634f)); sum += p[e]; }
        pw[kt * 2] = cvt_pk_bf16(p[0], p[1]); pw[kt * 2 + 1] = cvt_pk_bf16(p[2], p[3]); }
    sum += bperm((lane ^ (16)) << 2, sum); sum += bperm((lane ^ (32)) << 2, sum);
    const float inv = 1.0f / sum;
    f32x4 o[8];
#pragma unroll
    for (int dt = 0; dt < 8; ++dt) { o[dt] = (f32x4){0.f, 0.f, 0.f, 0.f};
#pragma unroll
        for (int ks = 0; ks < 8; ++ks) {
            const u32x2 lo = lds_tr16(vtr + (2 * ks) * 16 * 144 + dt * 16);
            const u32x2 hi = lds_tr16(vtr + (2 * ks + 1) * 16 * 144 + dt * 16);
            const u32x4 av = (u32x4){lo.x, lo.y, hi.x, hi.y};
            const u32x4 pv = (u32x4){pw[4 * ks], pw[4 * ks + 1], pw[4 * ks + 2], pw[4 * ks + 3]};
            o[dt] = __builtin_amdgcn_mfma_f32_16x16x32_bf16(__builtin_bit_cast(bf16x8, av), __builtin_bit_cast(bf16x8, pv), o[dt], 0, 0, 0); } }
    u32x2 rr[8];
#pragma unroll
    for (int dt = 0; dt < 8; ++dt) { const int d = dt * 16 + quad * 4;
        const u32x2 g = *(const u32x2*)(P + qrow * PW + 4608 + h * 128 + d);
        rr[dt].x = cvt_pk_bf16(o[dt][0] * inv * siluf_(bf_lo(g.x)), o[dt][1] * inv * siluf_(bf_hi(g.x)));
        rr[dt].y = cvt_pk_bf16(o[dt][2] * inv * siluf_(bf_lo(g.y)), o[dt][3] * inv * siluf_(bf_hi(g.y))); }
    store_row_tiles(mk_rsrc(Y23), (int)((qrow * 1024 + 512 + h * 128) * 2), rr, lane, quad);
}

__device__ __forceinline__ void pool_stage(LAS unsigned char* lds, const bf16_t* __restrict__ Wp  ) {
    LAS bf16_t* Ws = (LAS bf16_t*)lds;
    for (int c = tid_(); c < 2048; c += 512) { const int r = c >> 4, cc = c & 15; *(LAS u32x4*)(Ws + r * 136 + cc * 8) = *(const u32x4*)(Wp + r * 128 + cc * 8); }
}
template <int WIN>
__device__ __forceinline__ void pool_tile_w(LAS unsigned char* lds, const bf16_t* __restrict__ P, bf16_t* __restrict__ Y01, const float* __restrict__ pscale, const int g, const int tile) {
    const int tid = tid_(), lane = tid & 63, w = tid >> 6, ql = lane & 15, quad = lane >> 4;
    const LAS bf16_t* Ws = (const LAS bf16_t*)lds;
    LAS bf16_t* U = (LAS bf16_t*)(lds + 34816);
    u32x2 gq[8];
#pragma unroll
    for (int jt = 0; jt < 8; ++jt) gq[jt] = *(const u32x2*)(P + (size_t)(tile * 128 + w * 16 + ql) * PW + 2560 + g * 128 + jt * 16 + quad * 4);
    __syncthreads();
    for (int c = tid; c < 143 * 16; c += 512) { const int r = c >> 4, cc = c & 15; const int grow = tile * 128 - 15 + r;
        u32x4 v = (u32x4){0u, 0u, 0u, 0u};
        if (grow >= 0) v = *(const u32x4*)(P + (size_t)grow * PW + 2048 + g * 128 + cc * 8);
        *(LAS u32x4*)(U + r * 136 + cc * 8) = v; }
    __syncthreads();
    const int pos = tile * 128 + w * 16 + ql, lrow = 15 + w * 16 + ql;
    const int cnt = (pos + 1 < WIN) ? pos + 1 : WIN; const float rc = rcp_((float)cnt);
    bf16x8 bfm[4];
#pragma unroll
    for (int ks = 0; ks < 4; ++ks) {
        const LAS bf16_t* up = U + lrow * 136 + ks * 32 + quad * 8;
        const u32x4 c0 = *(const LAS u32x4*)up;
        const float a[8] = {bf_lo(c0.x), bf_hi(c0.x), bf_lo(c0.y), bf_hi(c0.y), bf_lo(c0.z), bf_hi(c0.z), bf_lo(c0.w), bf_hi(c0.w)};
        float sm[8];
#pragma unroll
        for (int e = 0; e < 8; ++e) sm[e] = a[e];
#pragma unroll
        for (int t = 1; t < WIN; ++t) { const u32x4 c1 = *(const LAS u32x4*)(up - t * 136);
            sm[0] += bf_lo(c1.x); sm[1] += bf_hi(c1.x); sm[2] += bf_lo(c1.y); sm[3] += bf_hi(c1.y); sm[4] += bf_lo(c1.z); sm[5] += bf_hi(c1.z); sm[6] += bf_lo(c1.w); sm[7] += bf_hi(c1.w); }
        u32x4 pk; pk.x = cvt_pk_bf16(sm[0] * rc - a[0], sm[1] * rc - a[1]); pk.y = cvt_pk_bf16(sm[2] * rc - a[2], sm[3] * rc - a[3]);
        pk.z = cvt_pk_bf16(sm[4] * rc - a[4], sm[5] * rc - a[5]); pk.w = cvt_pk_bf16(sm[6] * rc - a[6], sm[7] * rc - a[7]);
        bfm[ks] = __builtin_bit_cast(bf16x8, pk);
    }
    u32x2 rr[8];
#pragma unroll
    for (int jt = 0; jt < 8; ++jt) { f32x4 acc = (f32x4){0.f, 0.f, 0.f, 0.f};
#pragma unroll
        for (int ks = 0; ks < 4; ++ks) { const bf16x8 a = *(const LAS bf16x8*)(Ws + (jt * 16 + ql) * 136 + ks * 32 + quad * 8);
            acc = __builtin_amdgcn_mfma_f32_16x16x32_bf16(a, bfm[ks], acc, 0, 0, 0); }
        const int j = g * 128 + jt * 16 + quad * 4;
        const f32x4 ps = *(const f32x4*)(pscale + j);
        const u32x2 gg = gq[jt];
        rr[jt].x = cvt_pk_bf16(acc[0] * ps[0] * siluf_(bf_lo(gg.x)), acc[1] * ps[1] * siluf_(bf_hi(gg.x)));
        rr[jt].y = cvt_pk_bf16(acc[2] * ps[2] * siluf_(bf_lo(gg.y)), acc[3] * ps[3] * siluf_(bf_hi(gg.y))); }
    store_row_tiles(mk_rsrc(Y01), (pos * 1024 + 512 + g * 128) * 2, rr, lane, quad);
}
__device__ __forceinline__ void pool_tile(LAS unsigned char* lds, const bf16_t* __restrict__ P, bf16_t* __restrict__ Y01, const float* __restrict__ pscale, const int g, const int tile) {
    if (g == 0) pool_tile_w<2>(lds, P, Y01, pscale, g, tile);
    else if (g == 1) pool_tile_w<4>(lds, P, Y01, pscale, g, tile);
    else if (g == 2) pool_tile_w<8>(lds, P, Y01, pscale, g, tile);
    else pool_tile_w<16>(lds, P, Y01, pscale, g, tile);
}

#define XB_TMO      128
#define XB_XCNT(j)  (256  + 64 * (j))
#define XB_XSUB(j)  (1280 + 64 * (j))
#define XB_XGEN(j)  (2304 + 64 * (j))
#define XB_TOP      3328
#define XB_TOPGEN   3392
#define XCD_BAR_WORDS 3456
#define XB_SPIN_CAP (1u << 22)
__device__ __forceinline__ unsigned xb_ld(unsigned* p)              { return __hip_atomic_load(p, __ATOMIC_RELAXED, __HIP_MEMORY_SCOPE_AGENT); }
__device__ __forceinline__ unsigned xb_add(unsigned* p, unsigned v) { return __hip_atomic_fetch_add(p, v, __ATOMIC_RELAXED, __HIP_MEMORY_SCOPE_AGENT); }
__device__ __forceinline__ unsigned xb_xcc_id() { return (unsigned)__builtin_amdgcn_s_getreg((3 << 11) | 20) & 0xFu; }
#define XB_SPIN(cond, bar) do { unsigned _sp = 0; while (cond) { __builtin_amdgcn_s_sleep(1); \
    if ((++_sp & 255u) == 0u) { if (xb_ld(&(bar)[XB_TMO])) break; if (_sp > XB_SPIN_CAP) { atomicAdd(&(bar)[XB_TMO], 1u); break; } } } } while (0)
__device__ __forceinline__ void xcd_barrier_complete(unsigned* bar, unsigned x, unsigned& nloc, unsigned& nx) {
    const unsigned G = gridDim.x * gridDim.y * gridDim.z;
    unsigned sum, cnt, mine, sp = 0u;
    for (;;) {
        sum = 0u; cnt = 0u; mine = 0u;
#pragma unroll
        for (unsigned j = 0; j < 16; ++j) { const unsigned c = xb_ld(&bar[XB_XCNT(j)]); sum += c; cnt += (c > 0u) ? 1u : 0u; mine = (j == x) ? c : mine; }
        if (sum == G) break;
        __builtin_amdgcn_s_sleep(1);
        if ((++sp & 255u) == 0u) { if (xb_ld(&bar[XB_TMO])) break; if (sp > XB_SPIN_CAP) { atomicAdd(&bar[XB_TMO], 1u); break; } }
    }
    nloc = mine > 0u ? mine : 1u; nx = cnt > 0u ? cnt : 1u;
}
__device__ __forceinline__ void xcd_barrier(unsigned* bar, volatile LAS unsigned* st) {
    asm volatile("s_waitcnt vmcnt(0)" ::: "memory");
    __syncthreads();
    if (tid_() == 0) {
        const unsigned x = xb_xcc_id();
        __builtin_amdgcn_s_waitcnt(0);
        unsigned nloc = st[0], nx = st[1];
        if (nloc == 0u) { xcd_barrier_complete(bar, x, nloc, nx); st[0] = nloc; st[1] = nx; }
        const unsigned old = xb_add(&bar[XB_XSUB(x)], 1u);
        const unsigned gen = old / nloc;
        if (old + 1u == (gen + 1u) * nloc) {
            __builtin_amdgcn_fence(__ATOMIC_RELEASE, "agent");
            asm volatile("s_waitcnt vmcnt(0)" ::: "memory");
            const unsigned og = xb_add(&bar[XB_TOP], 1u);
            const unsigned tg = og / nx;
            if (og + 1u == (tg + 1u) * nx) xb_add(&bar[XB_TOPGEN], 1u);
            else XB_SPIN(xb_ld(&bar[XB_TOPGEN]) == tg, bar);
            __builtin_amdgcn_fence(__ATOMIC_ACQUIRE, "agent");
            xb_add(&bar[XB_XGEN(x)], 1u);
            asm volatile("s_waitcnt vmcnt(0)" ::: "memory");
        } else {
            XB_SPIN(xb_ld(&bar[XB_XGEN(x)]) == gen, bar);
            __builtin_amdgcn_fence(__ATOMIC_ACQUIRE, "agent");
            asm volatile("s_waitcnt vmcnt(0)" ::: "memory");
        }
    }
    __syncthreads();
}


__device__ __forceinline__ void flag_arrive(unsigned* cnt) {
    asm volatile("s_waitcnt vmcnt(0)" ::: "memory"); __syncthreads();
    if (tid_() == 0) { __builtin_amdgcn_fence(__ATOMIC_RELEASE, "agent"); asm volatile("s_waitcnt vmcnt(0)" ::: "memory"); (void)xb_add(cnt, 1u); }
}
__device__ __forceinline__ void flag_wait_nf(unsigned* cnt, unsigned target, unsigned* bar) {
    if (tid_() == 0) { XB_SPIN(xb_ld(cnt) < target, bar); }
    __syncthreads();
}
__device__ __forceinline__ float ld_agent(const float* p) { return __hip_atomic_load(p, __ATOMIC_RELAXED, __HIP_MEMORY_SCOPE_AGENT); }
__device__ __forceinline__ void flag_arrive_wt(unsigned* cnt) {
    asm volatile("s_waitcnt vmcnt(0)" ::: "memory"); __syncthreads();
    if (tid_() == 0) (void)xb_add(cnt, 1u);
}
__device__ __forceinline__ void flag_wait(unsigned* cnt, unsigned target, unsigned* bar) {
    if (tid_() == 0) { XB_SPIN(xb_ld(cnt) < target, bar); __builtin_amdgcn_fence(__ATOMIC_ACQUIRE, "agent"); asm volatile("s_waitcnt vmcnt(0)" ::: "memory"); }
    __syncthreads();
}
__device__ __forceinline__ void fold4(const float* base, const int n, const int quad, const int ql, float (&Po)[4], float (&Ho)[4]) {
    const int seg = (n + 3) >> 2, i0 = quad * seg; int i1 = i0 + seg; if (i1 > n) i1 = n;
    float Ps[4] = {1.f, 1.f, 1.f, 1.f}, Hs[4] = {0.f, 0.f, 0.f, 0.f};
#pragma unroll 4
    for (int i = i0; i < i1; ++i) {
#pragma unroll
        for (int nt = 0; nt < 4; ++nt) { const float a = ld_agent(base + (size_t)i * 1024 + nt * 16), bb = ld_agent(base + (size_t)i * 1024 + 512 + nt * 16); Hs[nt] = a * Hs[nt] + bb; Ps[nt] *= a; } }
#pragma unroll
    for (int nt = 0; nt < 4; ++nt) {
        const float P0 = bperm((ql) << 2, Ps[nt]), P1 = bperm((ql + 16) << 2, Ps[nt]), P2 = bperm((ql + 32) << 2, Ps[nt]), P3 = bperm((ql + 48) << 2, Ps[nt]);
        const float H0 = bperm((ql) << 2, Hs[nt]), H1 = bperm((ql + 16) << 2, Hs[nt]), H2 = bperm((ql + 32) << 2, Hs[nt]), H3 = bperm((ql + 48) << 2, Hs[nt]);
        Po[nt] = (P0 * P1) * (P2 * P3); Ho[nt] = ((H0 * P1 + H1) * P2 + H2) * P3 + H3; }
}

__device__ __forceinline__ void lru_stage(LAS unsigned char* lds, const float* cw, const float* cb, const float* brg, const float* big, const float* L) {
    LAS float* F = (LAS float*)lds;
    for (int i = tid_(); i < 2048; i += 512) F[i] = cw[i];
    { const int i = tid_(); F[2048 + i] = cb[i]; F[2560 + i] = brg[i]; F[3072 + i] = big[i];
      const float l = -L[i]; F[3584 + i] = fmaxf(l, 0.f) + log1pf(__expf(-fabsf(l))); }
}
template <bool FINAL>
__device__ __forceinline__ void lru_unit(LAS unsigned char* lds, const bf16_t* __restrict__ P, bf16_t* __restrict__ Y23, float* __restrict__ AGG, const float* __restrict__ GAGG,
                                         const bf16_t* __restrict__ Wrg, const bf16_t* __restrict__ Wig, unsigned char* __restrict__ cache, const int tile) {
    const int tid = tid_(), lane = tid & 63, hd = tid >> 6, ql = lane & 15, quad = lane >> 4;
    const LAS float* F = (const LAS float*)lds;
    LAS float* XC = (LAS float*)(lds + 16384 + hd * 7168);
    bf16x8 wr_[4][2], wi_[4][2];
#pragma unroll
    for (int nt = 0; nt < 4; ++nt)
#pragma unroll
        for (int ks = 0; ks < 2; ++ks) { const size_t o = (size_t)(hd * 64 + nt * 16 + ql) * 64 + ks * 32 + quad * 8;
            wr_[nt][ks] = *(const bf16x8*)(Wrg + o); wi_[nt][ks] = *(const bf16x8*)(Wig + o); }
    float hst[4] = {0.f, 0.f, 0.f, 0.f}, ptot[4] = {1.f, 1.f, 1.f, 1.f};
    if (FINAL) {
        float Pa[4], Ha[4], Pb[4], Hb[4];
        fold4(GAGG + hd * 64 + ql, tile >> 4, quad, ql, Pa, Ha);
        fold4(AGG + (size_t)(tile & ~15) * 1024 + hd * 64 + ql, tile & 15, quad, ql, Pb, Hb);
#pragma unroll
        for (int nt = 0; nt < 4; ++nt) hst[nt] = Pb[nt] * Ha[nt] + Hb[nt];
    }
    const int tk = lane >> 2, cg4 = (lane & 3) * 16, cb0 = hd * 64 + cg4;
    LAS bf16_t* UB = (LAS bf16_t*)(lds + 16384 + hd * 7168 + 4352);
    u32x4 pu[3];
    const int lrow = lane >> 3, lch = (lane & 7) * 8;
#define LRU_LOADU(T0) do { const bf16_t* ub_ = P + 3072 + hd * 64 + lch; \
        pu[0] = *(const u32x4*)(ub_ + (size_t)((T0) + lrow) * PW); pu[1] = *(const u32x4*)(ub_ + (size_t)((T0) + 8 + lrow) * PW); \
        { const int p = (T0) - 3 + lrow; pu[2] = (lane < 24 && p >= 0) ? *(const u32x4*)(ub_ + (size_t)(p < 0 ? 0 : p) * PW) : (u32x4){0u, 0u, 0u, 0u}; } } while (0)
    LRU_LOADU(tile * 64);
    for (int sub = 0; sub < 4; ++sub) {
        const int t0 = tile * 64 + sub * 16;
        {
            LDS_WAIT();
            *(LAS u32x4*)(UB + (3 + lrow) * 72 + lch) = pu[0]; *(LAS u32x4*)(UB + (11 + lrow) * 72 + lch) = pu[1];
            if (lane < 24) *(LAS u32x4*)(UB + lrow * 72 + lch) = pu[2];
            LDS_WAIT();
            if (sub < 3) LRU_LOADU(t0 + 16);
            float xc[16];
#pragma unroll
            for (int e = 0; e < 16; ++e) xc[e] = F[2048 + cb0 + e];
#pragma unroll
            for (int tap = 0; tap < 4; ++tap) {
                const u32x4 u0 = *(const LAS u32x4*)(UB + (tk + tap) * 72 + cg4), u1 = *(const LAS u32x4*)(UB + (tk + tap) * 72 + cg4 + 8);
                const float uv[16] = {bf_lo(u0.x), bf_hi(u0.x), bf_lo(u0.y), bf_hi(u0.y), bf_lo(u0.z), bf_hi(u0.z), bf_lo(u0.w), bf_hi(u0.w),
                                      bf_lo(u1.x), bf_hi(u1.x), bf_lo(u1.y), bf_hi(u1.y), bf_lo(u1.z), bf_hi(u1.z), bf_lo(u1.w), bf_hi(u1.w)};
#pragma unroll
                for (int e = 0; e < 16; ++e) xc[e] += F[tap * 512 + cb0 + e] * uv[e]; }
#pragma unroll
            for (int q = 0; q < 4; ++q) *(LAS f32x4*)(XC + tk * 68 + cg4 + q * 4) = (f32x4){xc[q * 4], xc[q * 4 + 1], xc[q * 4 + 2], xc[q * 4 + 3]};
            LDS_WAIT();
        }
        bf16x8 af[2];
#pragma unroll
        for (int ks = 0; ks < 2; ++ks) { const f32x4 a0 = *(const LAS f32x4*)(XC + ql * 68 + ks * 32 + quad * 8), a1 = *(const LAS f32x4*)(XC + ql * 68 + ks * 32 + quad * 8 + 4);
            u32x4 pk; pk.x = cvt_pk_bf16(a0[0], a0[1]); pk.y = cvt_pk_bf16(a0[2], a0[3]); pk.z = cvt_pk_bf16(a1[0], a1[1]); pk.w = cvt_pk_bf16(a1[2], a1[3]);
            af[ks] = __builtin_bit_cast(bf16x8, pk); }
#pragma unroll
        for (int nt = 0; nt < 4; ++nt) {
            f32x4 ar = (f32x4){0.f, 0.f, 0.f, 0.f}, ai = (f32x4){0.f, 0.f, 0.f, 0.f};
#pragma unroll
            for (int ks = 0; ks < 2; ++ks) { ar = __builtin_amdgcn_mfma_f32_16x16x32_bf16(af[ks], wr_[nt][ks], ar, 0, 0, 0); ai = __builtin_amdgcn_mfma_f32_16x16x32_bf16(af[ks], wi_[nt][ks], ai, 0, 0, 0); }
            const int c = hd * 64 + nt * 16 + ql;
            const float brg = F[2560 + c], big = F[3072 + c], spl = F[3584 + c];
            float av[4], bv[4]; unsigned cpk[4];
#pragma unroll
            for (int e = 0; e < 4; ++e) { const float xcv = XC[(quad * 4 + e) * 68 + nt * 16 + ql];
                const float r = sigmoidf_(ar[e] + brg), ig = sigmoidf_(ai[e] + big);
                const float la = -8.0f * r * spl; const float a = __expf(la);
                const float om = fmaxf(1.0f - a * a, 0.0f);
                const unsigned pkv = cvt_pk_bf16(la, __builtin_amdgcn_sqrtf(om) * ig * xcv); cpk[e] = pkv;
                av[e] = FINAL ? a : __expf(bf_lo(pkv)); bv[e] = bf_hi(pkv); }
            if (!FINAL) *(u32x4*)(cache + ((size_t)((sub * 4 + nt) * 512 + tid)) * 16) = (u32x4){cpk[0], cpk[1], cpk[2], cpk[3]};
            const float Pq = (av[0] * av[1]) * (av[2] * av[3]);
            const float Hq = ((bv[0] * av[1] + bv[1]) * av[2] + bv[2]) * av[3] + bv[3];
            const float P0 = bperm((ql) << 2, Pq), P1 = bperm((ql + 16) << 2, Pq), P2 = bperm((ql + 32) << 2, Pq), P3 = bperm((ql + 48) << 2, Pq);
            const float H0 = bperm((ql) << 2, Hq), H1 = bperm((ql + 16) << 2, Hq), H2 = bperm((ql + 32) << 2, Hq), H3 = bperm((ql + 48) << 2, Hq);
            const float c0 = hst[nt], c1 = P0 * c0 + H0, c2 = P1 * c1 + H1, c3 = P2 * c2 + H2;
            if (FINAL) {
                float hh = quad == 0 ? c0 : (quad == 1 ? c1 : (quad == 2 ? c2 : c3));
#pragma unroll
                for (int e = 0; e < 4; ++e) { hh = av[e] * hh + bv[e]; XC[(quad * 4 + e) * 68 + nt * 16 + ql] = hh; }
            }
            hst[nt] = P3 * c3 + H3; ptot[nt] *= (P0 * P1) * (P2 * P3);
        }
        if (FINAL) {
            LDS_WAIT();
            const size_t row = (size_t)t0 + tk;
            const bf16_t* gp = P + row * PW + 3584 + cb0; const u32x4 g0 = *(const u32x4*)gp, g1 = *(const u32x4*)(gp + 8);
            const f32x4 h0 = *(const LAS f32x4*)(XC + tk * 68 + cg4), h1 = *(const LAS f32x4*)(XC + tk * 68 + cg4 + 4), h2 = *(const LAS f32x4*)(XC + tk * 68 + cg4 + 8), h3 = *(const LAS f32x4*)(XC + tk * 68 + cg4 + 12);
            u32x4 o0, o1;
            o0.x = cvt_pk_bf16(h0[0] * siluf_(bf_lo(g0.x)), h0[1] * siluf_(bf_hi(g0.x))); o0.y = cvt_pk_bf16(h0[2] * siluf_(bf_lo(g0.y)), h0[3] * siluf_(bf_hi(g0.y)));
            o0.z = cvt_pk_bf16(h1[0] * siluf_(bf_lo(g0.z)), h1[1] * siluf_(bf_hi(g0.z))); o0.w = cvt_pk_bf16(h1[2] * siluf_(bf_lo(g0.w)), h1[3] * siluf_(bf_hi(g0.w)));
            o1.x = cvt_pk_bf16(h2[0] * siluf_(bf_lo(g1.x)), h2[1] * siluf_(bf_hi(g1.x))); o1.y = cvt_pk_bf16(h2[2] * siluf_(bf_lo(g1.y)), h2[3] * siluf_(bf_hi(g1.y)));
            o1.z = cvt_pk_bf16(h3[0] * siluf_(bf_lo(g1.z)), h3[1] * siluf_(bf_hi(g1.z))); o1.w = cvt_pk_bf16(h3[2] * siluf_(bf_lo(g1.w)), h3[3] * siluf_(bf_hi(g1.w)));
            bf16_t* yp = Y23 + row * 1024 + cb0; *(u32x4*)yp = o0; *(u32x4*)(yp + 8) = o1;
        }
    }
    if (!FINAL && quad == 0) {
#pragma unroll
        for (int nt = 0; nt < 4; ++nt) { const int c = hd * 64 + nt * 16 + ql; __hip_atomic_store(AGG + (size_t)tile * 1024 + c, ptot[nt], __ATOMIC_RELAXED, __HIP_MEMORY_SCOPE_AGENT); __hip_atomic_store(AGG + (size_t)tile * 1024 + 512 + c, hst[nt], __ATOMIC_RELAXED, __HIP_MEMORY_SCOPE_AGENT); }
    }
}


__device__ __forceinline__ void lru_final(LAS unsigned char* lds, const bf16_t* __restrict__ P, bf16_t* __restrict__ Y23, const float* __restrict__ AGG, const float* __restrict__ GAGG,
                                          const unsigned char* __restrict__ cache, const int tile) {
    const int tid = tid_(), lane = tid & 63, hd = tid >> 6, ql = lane & 15, quad = lane >> 4;
    LAS float* XC = (LAS float*)(lds + hd * 4352);
    float hst[4];
    {   float Pa[4], Ha[4], Pb[4], Hb[4];
        fold4(GAGG + hd * 64 + ql, tile >> 4, quad, ql, Pa, Ha);
        fold4(AGG + (size_t)(tile & ~15) * 1024 + hd * 64 + ql, tile & 15, quad, ql, Pb, Hb);
#pragma unroll
        for (int nt = 0; nt < 4; ++nt) hst[nt] = Pb[nt] * Ha[nt] + Hb[nt]; }
    const int tk = lane >> 2, cg4 = (lane & 3) * 16, cb0 = hd * 64 + cg4;
    u32x4 pk[4];
#pragma unroll
    for (int nt = 0; nt < 4; ++nt) pk[nt] = *(const u32x4*)(cache + ((size_t)(nt * 512 + tid)) * 16);
    for (int sub = 0; sub < 4; ++sub) {
        const int t0 = tile * 64 + sub * 16;
        const size_t row = (size_t)t0 + tk;
        const bf16_t* gp = P + row * PW + 3584 + cb0; const u32x4 g0 = *(const u32x4*)gp, g1 = *(const u32x4*)(gp + 8);
        u32x4 cur[4];
#pragma unroll
        for (int nt = 0; nt < 4; ++nt) cur[nt] = pk[nt];
        if (sub < 3) {
#pragma unroll
            for (int nt = 0; nt < 4; ++nt) pk[nt] = *(const u32x4*)(cache + ((size_t)(((sub + 1) * 4 + nt) * 512 + tid)) * 16); }
        LDS_WAIT();
#pragma unroll
        for (int nt = 0; nt < 4; ++nt) {
            const unsigned cw[4] = {cur[nt].x, cur[nt].y, cur[nt].z, cur[nt].w};
            float av[4], bv[4];
#pragma unroll
            for (int e = 0; e < 4; ++e) { av[e] = __expf(bf_lo(cw[e])); bv[e] = bf_hi(cw[e]); }
            const float Pq = (av[0] * av[1]) * (av[2] * av[3]);
            const float Hq = ((bv[0] * av[1] + bv[1]) * av[2] + bv[2]) * av[3] + bv[3];
            const float P0 = bperm((ql) << 2, Pq), P1 = bperm((ql + 16) << 2, Pq), P2 = bperm((ql + 32) << 2, Pq), P3 = bperm((ql + 48) << 2, Pq);
            const float H0 = bperm((ql) << 2, Hq), H1 = bperm((ql + 16) << 2, Hq), H2 = bperm((ql + 32) << 2, Hq), H3 = bperm((ql + 48) << 2, Hq);
            const float c0 = hst[nt], c1 = P0 * c0 + H0, c2 = P1 * c1 + H1, c3 = P2 * c2 + H2;
            float hh = quad == 0 ? c0 : (quad == 1 ? c1 : (quad == 2 ? c2 : c3));
#pragma unroll
            for (int e = 0; e < 4; ++e) { hh = av[e] * hh + bv[e]; XC[(quad * 4 + e) * 68 + nt * 16 + ql] = hh; }
            hst[nt] = P3 * c3 + H3;
        }
        LDS_WAIT();
        const f32x4 h0 = *(const LAS f32x4*)(XC + tk * 68 + cg4), h1 = *(const LAS f32x4*)(XC + tk * 68 + cg4 + 4), h2 = *(const LAS f32x4*)(XC + tk * 68 + cg4 + 8), h3 = *(const LAS f32x4*)(XC + tk * 68 + cg4 + 12);
        u32x4 o0, o1;
        o0.x = cvt_pk_bf16(h0[0] * siluf_(bf_lo(g0.x)), h0[1] * siluf_(bf_hi(g0.x))); o0.y = cvt_pk_bf16(h0[2] * siluf_(bf_lo(g0.y)), h0[3] * siluf_(bf_hi(g0.y)));
        o0.z = cvt_pk_bf16(h1[0] * siluf_(bf_lo(g0.z)), h1[1] * siluf_(bf_hi(g0.z))); o0.w = cvt_pk_bf16(h1[2] * siluf_(bf_lo(g0.w)), h1[3] * siluf_(bf_hi(g0.w)));
        o1.x = cvt_pk_bf16(h2[0] * siluf_(bf_lo(g1.x)), h2[1] * siluf_(bf_hi(g1.x))); o1.y = cvt_pk_bf16(h2[2] * siluf_(bf_lo(g1.y)), h2[3] * siluf_(bf_hi(g1.y)));
        o1.z = cvt_pk_bf16(h3[0] * siluf_(bf_lo(g1.z)), h3[1] * siluf_(bf_hi(g1.z))); o1.w = cvt_pk_bf16(h3[2] * siluf_(bf_lo(g1.w)), h3[3] * siluf_(bf_hi(g1.w)));
        bf16_t* yp = Y23 + row * 1024 + cb0; *(u32x4*)yp = o0; *(u32x4*)(yp + 8) = o1;
    }
}

typedef const __attribute__((address_space(4))) Args* ArgsP;
__device__ __forceinline__ ArgsP args_ptr() { ArgsP p = (ArgsP)__builtin_amdgcn_kernarg_segment_ptr(); asm volatile("" : "+s"(p)); return p; }
__global__ void __launch_bounds__(512, 2) mk_fwd(Args a_unused) {
    extern __shared__ __attribute__((aligned(16))) unsigned char lds_[];
    LAS unsigned char* lds = (LAS unsigned char*)lds_;
    cg::grid_group grid = cg::this_grid();
    volatile LAS unsigned* bst = (volatile LAS unsigned*)(lds + LDS_BARW);
    { ArgsP ap0 = args_ptr(); unsigned* bar0 = (unsigned*)(ap0->ws);
      if (tid_() == 0) { bst[0] = 0u; bst[1] = 0u; (void)xb_add(&bar0[XB_XCNT(xb_xcc_id())], 1u); } }
#define GRID_BAR() do { ArgsP apb = args_ptr(); xcd_barrier((unsigned*)(apb->ws), bst); } while (0)

    {
        __syncthreads();
        ArgsP ap = args_ptr(); unsigned char* ws = ap->ws;
        const int tid = tid_(), lane = tid & 63, wave = __builtin_amdgcn_readfirstlane(tid >> 6), c = bid_(), G = gridDim.x;
        bf16_t* Wpool_t = (bf16_t*)(ws + WS_SMALL); bf16_t* Wrg_t = (bf16_t*)(ws + WS_SMALL + 262144); bf16_t* Wig_t = (bf16_t*)(ws + WS_SMALL + 262144 + 131072);
        bf16_t* MEMB = (bf16_t*)(ws + WS_MEMB); bf16_t* Win_t = (bf16_t*)(ws + WS_WIN); bf16_t* Wb_t = (bf16_t*)(ws + WS_WB); bf16_t* Wo_t = (bf16_t*)(ws + WS_WO); bf16_t* Wkv_t = (bf16_t*)(ws + WS_WKV);
        bf16_t* XN = (bf16_t*)(ws + WS_XN);
        LAS float* scr = (LAS float*)(lds + wave * 16384);
        const int gw = c * 8 + wave, NGW = G * 8;
        constexpr int I_IN = 16 * 288, I_BR = 8 * 32, I_SQ = 16 * 32, I_PL = 2 * 4, I_RG = 1 * 2;
        constexpr int N_IN = 2 * I_IN, N_BR = 8 * I_BR, N_O = 2 * I_SQ, N_KV = 2 * I_SQ, N_PL = 8 * I_PL, N_RG = 16 * I_RG;
        constexpr int NITEMS = N_IN + N_BR + N_O + N_KV + N_PL + 2 * N_RG;
#define P0_DECODE(IT, T) do { int r_ = (IT); \
            if (r_ < N_IN) { const int l_ = r_ / I_IN; T = TItem{ap->w_in + (size_t)l_ * DM * NIN, Win_t + (size_t)l_ * NIN * DM, NIN, DM, r_ % I_IN}; break; } r_ -= N_IN; \
            if (r_ < N_BR) { const int q_ = r_ / I_BR; T = TItem{ap->w_branch + (size_t)q_ * 512 * DM, Wb_t + (size_t)q_ * 1024 * 1024, DM, 1024, r_ % I_BR}; break; } r_ -= N_BR; \
            if (r_ < N_O) { const int l_ = r_ / I_SQ; T = TItem{ap->w_out + (size_t)l_ * DM * DM, Wo_t + (size_t)l_ * DM * DM, DM, DM, r_ % I_SQ}; break; } r_ -= N_O; \
            if (r_ < N_KV) { const int l_ = r_ / I_SQ; T = TItem{ap->w_mem_kv + (size_t)l_ * DM * DM, Wkv_t + (size_t)l_ * DM * DM, DM, DM, r_ % I_SQ}; break; } r_ -= N_KV; \
            if (r_ < N_PL) { const int q_ = r_ / I_PL; T = TItem{ap->w_pool + (size_t)q_ * 128 * 128, Wpool_t + (size_t)q_ * 128 * 128, 128, 128, r_ % I_PL}; break; } r_ -= N_PL; \
            if (r_ < N_RG) { const int q_ = r_ / I_RG; T = TItem{ap->w_rg + (size_t)q_ * 64 * 64, Wrg_t + (size_t)q_ * 64 * 64, 64, 64, r_ % I_RG}; break; } r_ -= N_RG; \
            { const int q_ = r_ / I_RG; T = TItem{ap->w_ig + (size_t)q_ * 64 * 64, Wig_t + (size_t)q_ * 64 * 64, 64, 64, r_ % I_RG}; } } while (0)
        for (int it = gw; it < NITEMS; it += 2 * NGW) {
            const bool hb = (it + NGW < NITEMS);
            TItem ta_, tb_; P0_DECODE(it, ta_); P0_DECODE(hb ? it + NGW : it, tb_);
            f32x4 va[8], vb[8];
            tr_load(ta_, lane, va); if (hb) tr_load(tb_, lane, vb);
            tr_finish(ta_, lane, va, scr); if (hb) tr_finish(tb_, lane, vb, scr);
        }
        const float* x = ap->x; const float* mem = ap->mem;
        const size_t gt = (size_t)c * 512 + tid, GT = (size_t)G * 512;
        for (size_t i = gt; i < (size_t)NBATCH * SEQ * DM / 8; i += 4 * GT) {
            f32x4 v0[4], v1[4];
#pragma unroll
            for (int q = 0; q < 4; ++q) { v0[q] = *(const f32x4*)(x + (i + q * GT) * 8); v1[q] = *(const f32x4*)(x + (i + q * GT) * 8 + 4); }
#pragma unroll
            for (int q = 0; q < 4; ++q) { u32x4 o; o.x = cvt_pk_bf16(v0[q][0], v0[q][1]); o.y = cvt_pk_bf16(v0[q][2], v0[q][3]); o.z = cvt_pk_bf16(v1[q][0], v1[q][1]); o.w = cvt_pk_bf16(v1[q][2], v1[q][3]);
                *(u32x4*)(XN + (i + q * GT) * 8) = o; } }
        for (size_t i = gt; i < (size_t)NBATCH * MEMLEN * DM / 8; i += GT) { const f32x4 v0 = *(const f32x4*)(mem + i * 8), v1 = *(const f32x4*)(mem + i * 8 + 4);
            u32x4 o; o.x = pk2(v0[0], v0[1]); o.y = pk2(v0[2], v0[3]); o.z = pk2(v1[0], v1[1]); o.w = pk2(v1[2], v1[3]); *(u32x4*)(MEMB + i * 8) = o; }
    }
    if (gridDim.x == 0x7fffffffu) grid.sync();
    GRID_BAR();

    for (int l = 0; l < NLAYER; ++l) {
        for (int b = 0; b < NBATCH; ++b) {
            {
                __syncthreads();
                ArgsP ap = args_ptr(); unsigned char* ws = ap->ws; const int c = bid_();
                SchedP1 S{(const char*)(ws + WS_XN) + (size_t)b * SEQ * DM * 2, (const char*)(ws + WS_WIN) + (size_t)l * NIN * DM * 2, c};
                EpiP1 E{(bf16_t*)(ws + WS_PROJ), PW};
                pg8::gemm_phase<EpiP1, SchedP1, true>(lds, 2048, 2048, S, E);
            }
            if (l == 0 && b == 0) {
                ArgsP ap = args_ptr(); unsigned char* ws = ap->ws; const int c = bid_();
                __syncthreads();
                SchedKV S{(const char*)(ws + WS_MEMB), (const char*)(ws + WS_WKV), c};
                EpiP1 E{(bf16_t*)(ws + WS_KVM) + (size_t)(c >> 3) * 512 * 1024, 1024};
                pg8::gemm_phase<EpiP1, SchedKV, true>(lds, 2048, 2048, S, E);
            }
            GRID_BAR();
            {
                ArgsP ap = args_ptr(); unsigned char* ws = ap->ws; const int c = bid_();
                const bf16_t* PROJ = (const bf16_t*)(ws + WS_PROJ); bf16_t* Y23 = (bf16_t*)(ws + WS_Y) + (size_t)16384 * 1024;
                float* AGG = (float*)(ws + WS_AGG); float* GAGG = AGG + 256 * 1024;
                unsigned* bar = (unsigned*)ws; unsigned* cnt1 = bar + 3584 + 64 * (l * 2 + b); unsigned* cnt2 = bar + 3584 + 64 * (4 + l * 2 + b);
                __syncthreads();
                lru_stage(lds, ap->conv_w + (size_t)l * 2048, ap->conv_b + l * 512, ap->b_rg + l * 512, ap->b_ig + l * 512, ap->lru_L + l * 512);
                __syncthreads();
                lru_unit<false>(lds, PROJ, Y23, AGG, GAGG, (const bf16_t*)(ws + WS_SMALL + 262144) + (size_t)l * 32768, (const bf16_t*)(ws + WS_SMALL + 262144 + 131072) + (size_t)l * 32768, ws + WS_GSCR + ((size_t)c * 4 + 3) * 131072, c);
                flag_arrive_wt(cnt1);
                __syncthreads();
            }
            {
                __syncthreads();
                ArgsP ap = args_ptr(); unsigned char* ws = ap->ws; const int c = bid_(), G = gridDim.x;
                const bf16_t* PROJ = (const bf16_t*)(ws + WS_PROJ); bf16_t* Y01 = (bf16_t*)(ws + WS_Y);
                for (int u = c; u < 512; u += G) sb_unit(lds, PROJ, Y01, u & 3, tile_of(u));
                __syncthreads();
            }
            {
                ArgsP ap = args_ptr(); unsigned char* ws = ap->ws; const int c = bid_();
                float* AGG = (float*)(ws + WS_AGG); float* GAGG = AGG + 256 * 1024;
                unsigned* bar = (unsigned*)ws; unsigned* cnt1 = bar + 3584 + 64 * (l * 2 + b); unsigned* cnt2 = bar + 3584 + 64 * (4 + l * 2 + b);
                if (c < 16) {
                    flag_wait_nf(cnt1, 256u, bar);
                    const int ch = tid_(); float Pg = 1.f, Hg = 0.f; const float* ab = AGG + (size_t)c * 16 * 1024 + ch;
#pragma unroll
                    for (int i = 0; i < 16; ++i) { const float a = ld_agent(ab + i * 1024), bb = ld_agent(ab + i * 1024 + 512); Hg = a * Hg + bb; Pg *= a; }
                    __hip_atomic_store(GAGG + c * 1024 + ch, Pg, __ATOMIC_RELAXED, __HIP_MEMORY_SCOPE_AGENT); __hip_atomic_store(GAGG + c * 1024 + 512 + ch, Hg, __ATOMIC_RELAXED, __HIP_MEMORY_SCOPE_AGENT);
                    flag_arrive_wt(cnt2);
                }
            }
            {
                __syncthreads();
                ArgsP ap = args_ptr(); unsigned char* ws = ap->ws; const int c = bid_(), G = gridDim.x;
                const bf16_t* PROJ = (const bf16_t*)(ws + WS_PROJ); bf16_t* Y01 = (bf16_t*)(ws + WS_Y);
                const bf16_t* Wpool_t = (const bf16_t*)(ws + WS_SMALL); const float* psc = ap->pool_scale + l * 512;
                int gcur = -1;
                for (int u = c; u < 512; u += G) { const int g = u & 3;
                    if (g != gcur) { __syncthreads(); pool_stage(lds, Wpool_t + (size_t)(l * 4 + g) * 16384); __syncthreads(); gcur = g; }
                    pool_tile(lds, PROJ, Y01, psc, g, tile_of(u)); }
                __syncthreads();
            }
            {
                __syncthreads();
                ArgsP ap = args_ptr(); unsigned char* ws = ap->ws; const int c = bid_(), G = gridDim.x;
                const bf16_t* PROJ = (const bf16_t*)(ws + WS_PROJ); bf16_t* Y23 = (bf16_t*)(ws + WS_Y) + (size_t)16384 * 1024;
                const bf16_t* KVM = (const bf16_t*)(ws + WS_KVM) + (size_t)l * 512 * 1024 + (size_t)b * 256 * 1024;
                int hcur = -1;
                for (int u = c; u < 512; u += G) { const int h = u & 3;
                    if (h != hcur) { __syncthreads(); xa_stage(lds, KVM, h); __syncthreads(); hcur = h; }
                    xa_tile(lds, PROJ, Y23, h, u >> 2); }
            }
            {
                ArgsP ap = args_ptr(); unsigned char* ws = ap->ws; const int c = bid_();
                const bf16_t* PROJ = (const bf16_t*)(ws + WS_PROJ); bf16_t* Y23 = (bf16_t*)(ws + WS_Y) + (size_t)16384 * 1024;
                float* AGG = (float*)(ws + WS_AGG); float* GAGG = AGG + 256 * 1024;
                unsigned* bar = (unsigned*)ws; unsigned* cnt2 = bar + 3584 + 64 * (4 + l * 2 + b);
                __syncthreads();
                flag_wait_nf(cnt2, 16u, bar);
                lru_final(lds, PROJ, Y23, AGG, GAGG, ws + WS_GSCR + ((size_t)c * 4 + 3) * 131072, c);
            }
            {
                __syncthreads();
                ArgsP ap = args_ptr(); unsigned char* ws = ap->ws; const int c = bid_();
                SchedP3G S{(const char*)(ws + WS_XN) + (size_t)b * SEQ * DM * 2, (const char*)(ws + WS_WIN) + ((size_t)l * NIN + 5120) * DM * 2, c};
                EpiP3G E{ws + WS_GSCR + (size_t)c * 4 * 131072};
                pg8::gemm_phase<EpiP3G, SchedP3G, true>(lds, 2048, 2048, S, E);
            }
            GRID_BAR();
            {
                __syncthreads();
                ArgsP ap = args_ptr(); unsigned char* ws = ap->ws; const int c = bid_();
                SchedP3B S2{(const char*)(ws + WS_Y), (const char*)(ws + WS_WB) + (size_t)l * 4 * 1024 * 1024 * 2, c};
                EpiP3B E2{ws + WS_GSCR + (size_t)c * 4 * 131072, (bf16_t*)(ws + WS_GSCR + (size_t)c * 4 * 131072)};
                pg8::gemm_phase<EpiP3B, SchedP3B, true>(lds, 2048, 2048, S2, E2);
            }
            {
                ArgsP ap = args_ptr(); unsigned char* ws = ap->ws; const int c = bid_();
                const int pm = 8 * (c & 7) + ((c >> 3) >> 2);
                unsigned* bar = (unsigned*)ws; unsigned* cntA = bar + 4096 + (((l * 2 + b) * 2 + 0) * 64 + pm) * 16; unsigned* cntB = bar + 4096 + (((l * 2 + b) * 2 + 1) * 64 + pm) * 16;
                flag_arrive_wt(cntA);
                flag_wait(cntA, 4u, bar);
                const float* xres = (l == 0 ? ap->x : (const float*)ap->out) + (size_t)b * SEQ * DM;
                SchedP4 S{(const char*)(ws + WS_GSCR), (const char*)(ws + WS_WO) + (size_t)l * DM * DM * 2, c};
                EpiP4 E{xres, ap->out + (size_t)b * SEQ * DM, (l + 1 < NLAYER) ? (bf16_t*)(ws + WS_XN) + (size_t)b * SEQ * DM : (bf16_t*)nullptr, ap->ln_g + l * DM, ap->ln_b + l * DM,
                        (float*)(ws + WS_AGG + 1536 * 1024), cntB, bar};
                pg8::gemm_phase<EpiP4, SchedP4, true, true>(lds, 512, 2048, S, E);
            }
        }
    }
}

extern "C" void kernel_launch(void* const* d_in, const int* in_sizes, int n_in, void* d_out, int out_size, void* d_ws, size_t ws_size, hipStream_t stream) {
    static int ok = 0;
    if (ok == 0) {
        ok = 1;
        if (n_in != 17 || ws_size < WS_END) { fprintf(stderr, "kernel_launch: unexpected inputs (n_in %d, ws %zu)\n", n_in, ws_size); ok = -1; }
        if (hipFuncSetAttribute((const void*)mk_fwd, hipFuncAttributeMaxDynamicSharedMemorySize, LDS_BYTES) != hipSuccess) { fprintf(stderr, "kernel_launch: hipFuncSetAttribute failed\n"); ok = -1; }
        (void)hipGetLastError();
    }
    if (ok < 0) return;
    Args a{};
    a.x = (const float*)d_in[0]; a.mem = (const float*)d_in[1]; a.w_in = (const float*)d_in[2]; a.w_pool = (const float*)d_in[3]; a.pool_scale = (const float*)d_in[4];
    a.conv_w = (const float*)d_in[5]; a.conv_b = (const float*)d_in[6]; a.w_rg = (const float*)d_in[7]; a.b_rg = (const float*)d_in[8]; a.w_ig = (const float*)d_in[9];
    a.b_ig = (const float*)d_in[10]; a.lru_L = (const float*)d_in[11]; a.w_mem_kv = (const float*)d_in[12]; a.w_branch = (const float*)d_in[13]; a.w_out = (const float*)d_in[14];
    a.ln_g = (const float*)d_in[15]; a.ln_b = (const float*)d_in[16]; a.out = (float*)d_out; a.ws = (unsigned char*)d_ws;
    (void)hipMemsetAsync(d_ws, 0, 49152, stream);
    void* args[] = {&a};
    hipError_t e = hipLaunchCooperativeKernel((const void*)mk_fwd, dim3(256), dim3(512), args, LDS_BYTES, stream);
    if (e != hipSuccess) fprintf(stderr, "kernel_launch: cooperative launch failed: %s\n", hipGetErrorString(e));
}
```

```cpp
#include <hip/hip_runtime.h>
#include <hip/hip_cooperative_groups.h>
#include <cstdio>
#include <cstdint>
namespace cg = cooperative_groups;

#define LAS __attribute__((address_space(3)))
typedef unsigned short bf16_t;
typedef short bf16x8 __attribute__((ext_vector_type(8)));
typedef float f32x4 __attribute__((ext_vector_type(4)));
typedef unsigned u32x4 __attribute__((ext_vector_type(4)));
typedef unsigned u32x2 __attribute__((ext_vector_type(2)));

constexpr int DM = 1024, SEQ = 16384, NBATCH = 2, NIN = 9216, PW = 5120, MEMLEN = 256, NLAYER = 2;
constexpr float DN_ALPHA = 1.41421356237f, LN_EPS = 1e-5f;
constexpr size_t MiB = 1024 * 1024;
constexpr size_t WS_SMALL = 1 * MiB;
constexpr size_t WS_MEMB = 2 * MiB;
constexpr size_t WS_KVM = 3 * MiB;
constexpr size_t WS_AGG = 5 * MiB;
constexpr size_t WS_WIN = 8 * MiB;
constexpr size_t WS_WB = 44 * MiB;
constexpr size_t WS_WO = 60 * MiB;
constexpr size_t WS_WKV = 64 * MiB;
constexpr size_t WS_XN = 72 * MiB;
constexpr size_t WS_PROJ = 136 * MiB;
constexpr size_t WS_Y = 296 * MiB;
constexpr size_t WS_GSCR = 360 * MiB;
constexpr size_t WS_END = 488 * MiB;
constexpr int LDS_BYTES = 147456;
constexpr int LDS_BARW = 147456 - 64;

__device__ __forceinline__ unsigned cvt_pk_bf16(float lo, float hi) { unsigned r; asm volatile("v_cvt_pk_bf16_f32 %0, %1, %2" : "=v"(r) : "v"(lo), "v"(hi)); return r; }
__device__ __forceinline__ float bf_lo(unsigned u) { return __uint_as_float(u << 16); }
__device__ __forceinline__ float bf_hi(unsigned u) { return __uint_as_float(u & 0xffff0000u); }
__device__ __forceinline__ float bf1(bf16_t u) { return __uint_as_float(((unsigned)u) << 16); }
__device__ __forceinline__ float rcp_(float x) { return __builtin_amdgcn_rcpf(x); }
__device__ __forceinline__ float sigmoidf_(float x) { return rcp_(1.0f + __expf(-x)); }
__device__ __forceinline__ float siluf_(float x) { return x * rcp_(1.0f + __expf(-x)); }
__device__ __forceinline__ int tid_() { int t = threadIdx.x; asm volatile("" : "+v"(t)); return t; }
__device__ __forceinline__ int bid_() { int t = blockIdx.x; asm volatile("" : "+s"(t)); return t; }
__device__ __forceinline__ float bperm(int addr4, float v) { return __int_as_float(__builtin_amdgcn_ds_bpermute(addr4, __float_as_int(v))); }
typedef short s16x4 __attribute__((ext_vector_type(4)));
__device__ __forceinline__ u32x2 lds_tr16(const LAS bf16_t* p) { return __builtin_bit_cast(u32x2, __builtin_amdgcn_ds_read_tr16_b64_v4i16((LAS s16x4*)p)); }
__device__ __forceinline__ __amdgpu_buffer_rsrc_t mk_rsrc(const void* p) { return __builtin_amdgcn_make_buffer_rsrc((void*)p, 0, 0x7fffffff, 0x00020000); }
__device__ __forceinline__ void st_wt16(__amdgpu_buffer_rsrc_t rs, int byte_off, u32x4 v) { __builtin_amdgcn_raw_buffer_store_b128(v, rs, byte_off, 0, 16); }
__device__ __forceinline__ void st_wt8(__amdgpu_buffer_rsrc_t rs, int byte_off, u32x2 v) { __builtin_amdgcn_raw_buffer_store_b64(v, rs, byte_off, 0, 16); }
__device__ __forceinline__ int tile_of(int u) { return ((((u & 7) >> 2) * 2 + (u >> 8)) * 32) + ((u & 255) >> 3); }
__device__ __forceinline__ void store_row_tiles(const __amdgpu_buffer_rsrc_t rs, const int base_byte, const u32x2 (&r)[8], const int lane, const int quad) {
    const bool odd = (quad & 1) != 0; const int pa = (lane ^ 16) << 2;
#pragma unroll
    for (int tp = 0; tp < 4; ++tp) {
        const u32x2 mine0 = r[2 * tp], mine1 = r[2 * tp + 1];
        const u32x2 snd = odd ? mine0 : mine1; u32x2 rcv;
        rcv.x = (unsigned)__builtin_amdgcn_ds_bpermute(pa, (int)snd.x); rcv.y = (unsigned)__builtin_amdgcn_ds_bpermute(pa, (int)snd.y);
        const u32x4 o = odd ? (u32x4){rcv.x, rcv.y, mine1.x, mine1.y} : (u32x4){mine0.x, mine0.y, rcv.x, rcv.y};
        const int d = odd ? (2 * tp + 1) * 16 + (quad - 1) * 4 : (2 * tp) * 16 + quad * 4;
        __builtin_amdgcn_raw_buffer_store_b128(o, rs, base_byte + d * 2, 0, 0); }
}
#define LDS_WAIT() asm volatile("s_waitcnt lgkmcnt(0)" ::: "memory")

__device__ __forceinline__ void flag_arrive(unsigned* cnt);
__device__ __forceinline__ void flag_arrive_wt(unsigned* cnt);
__device__ __forceinline__ void flag_wait_nf(unsigned* cnt, unsigned target, unsigned* bar);
__device__ __forceinline__ void flag_wait(unsigned* cnt, unsigned target, unsigned* bar);
namespace pg8 {
constexpr int BM = 256, BK = 64, HALF = 128, HTB = HALF * BK * 2;
__device__ __forceinline__ int lds_byte(int r, int c) { const int st = (r >> 4) * 2 + (c >> 5), rr = r & 15, cc = c & 31, ob = rr * 64 + cc * 2; return st * 1024 + (ob ^ (((ob >> 9) & 1) << 5)); }
__device__ __forceinline__ void stage_rc(int b, int& R, int& C) { const int st = b / 1024, sb = b % 1024, swz = sb ^ (((sb >> 9) & 1) << 5); R = (st >> 1) * 16 + swz / 64; C = (st & 1) * 32 + (swz % 64) / 2; }
__device__ __forceinline__ int perm32(int rho) { const int n = rho >> 4, i = rho & 15; return 8 * (i >> 2) + 4 * n + (i & 3); }

struct UD { const char* A; const char* B; int nt, kind, pm, pn, aux; };

template <class Epi, class Sched, bool ALIGN_EPI, bool AFTER_DRAIN = false>
__device__ __forceinline__ void gemm_phase(LAS unsigned char* lds, const int lda2, const int ldb2, const Sched& S, const Epi& E) {
    const int tid = tid_(), wid = __builtin_amdgcn_readfirstlane(tid >> 6), lane = tid & 63, wr = wid >> 2, wc = wid & 3, fr = lane & 15, fq = lane >> 4;
    unsigned voffA[2], voffB[2];
#pragma unroll
    for (int i = 0; i < 2; ++i) { int R, C; stage_rc(tid * 16 + i * 8192, R, C); const int Rb = Epi::PERM ? ((R & ~31) + perm32(R & 31)) : R;
        voffA[i] = (unsigned)(R * lda2 + C * 2); voffB[i] = (unsigned)(Rb * ldb2 + C * 2); }
    const size_t kstep = (size_t)(BK * 2);
    const size_t hA = (size_t)HALF * lda2, hB = (size_t)HALF * ldb2;
    const unsigned ldsw = (unsigned)wid * 1024u;
    const int aoff = lds_byte(wr * 64 + fr, fq * 8), boff = lds_byte(wc * 32 + fr, fq * 8);
#define PG8_SA(b, h) (((b) * 2 + (h)) * HTB)
#define PG8_SB(b, h) ((4 + (b) * 2 + (h)) * HTB)
#define PG8_STAGE(bufoff, gbase, voff) do { _Pragma("unroll") for (int _i = 0; _i < 2; ++_i) \
        __builtin_amdgcn_global_load_lds((const unsigned*)((const char*)(gbase) + (voff)[_i]), (LAS unsigned*)(lds + (bufoff) + ldsw + _i * 8192), 16, 0, 0); } while (0)
#define PG8_LDA(dst, b, h) do { _Pragma("unroll") for (int m = 0; m < 4; ++m) _Pragma("unroll") for (int k = 0; k < 2; ++k) dst[m][k] = *(const LAS bf16x8*)(lds + PG8_SA(b, h) + aoff + m * 2048 + k * 1024); } while (0)
#define PG8_LDB(dst, b, h) do { _Pragma("unroll") for (int n = 0; n < 2; ++n) _Pragma("unroll") for (int k = 0; k < 2; ++k) dst[n][k] = *(const LAS bf16x8*)(lds + PG8_SB(b, h) + boff + n * 2048 + k * 1024); } while (0)
#define PG8_MMA(ai, bj, At, Bt) do { __builtin_amdgcn_s_setprio(1); _Pragma("unroll") for (int m = 0; m < 4; ++m) _Pragma("unroll") for (int n = 0; n < 2; ++n) _Pragma("unroll") for (int k = 0; k < 2; ++k) \
        acc[ai][bj][m][n] = __builtin_amdgcn_mfma_f32_16x16x32_bf16(Bt[n][k], At[m][k], acc[ai][bj][m][n], 0, 0, 0); __builtin_amdgcn_s_setprio(0); } while (0)
#define PG8_WAIT_V(n) asm volatile("s_waitcnt vmcnt(" #n ")" ::: "memory")
#define PG8_WAIT_L(n) asm volatile("s_waitcnt lgkmcnt(" #n ")" ::: "memory")
#define PG8_BAR __builtin_amdgcn_s_barrier()
#define PG8_SCHED __builtin_amdgcn_sched_barrier(0)
    UD cur, nxt; int ui = 0;
    if (!S.next(0, cur)) return;
    f32x4 acc[2][2][4][2];
#pragma unroll
    for (int a = 0; a < 2; ++a)
#pragma unroll
        for (int b = 0; b < 2; ++b)
#pragma unroll
            for (int m = 0; m < 4; ++m)
#pragma unroll
                for (int n = 0; n < 2; ++n) acc[a][b][m][n] = (f32x4){0.f, 0.f, 0.f, 0.f};
    bf16x8 At[4][2], B0[2][2], B1[2][2];
    const char* cA = cur.A; const char* cB = cur.B;
    PG8_STAGE(PG8_SB(0, 0), cB, voffB); PG8_STAGE(PG8_SB(0, 1), cB + hB, voffB); PG8_STAGE(PG8_SA(0, 0), cA, voffA); PG8_STAGE(PG8_SA(0, 1), cA + hA, voffA);
    if (wr == 1) PG8_BAR;
    PG8_WAIT_V(2); PG8_BAR;
    PG8_STAGE(PG8_SB(1, 0), cB + kstep, voffB); PG8_STAGE(PG8_SA(1, 0), cA + kstep, voffA); PG8_STAGE(PG8_SB(1, 1), cB + hB + kstep, voffB);
    PG8_WAIT_V(6); PG8_BAR;
    for (;;) {
        const bool has_next = S.next(ui + 1, nxt);
        const char* nA = has_next ? nxt.A : cA; const char* nB = has_next ? nxt.B : cB;
        const int nt = cur.nt;
        for (int t = 0; t < nt; t += 2) {
            const bool last = (t == nt - 2);
            const char* a1 = cA + (size_t)(t + 1) * kstep;
            const char* a2 = last ? nA : cA + (size_t)(t + 2) * kstep; const char* b2 = last ? nB : cB + (size_t)(t + 2) * kstep;
            const char* a3 = a2 + kstep; const char* b3 = b2 + kstep;
            PG8_LDB(B0, 0, 0); PG8_LDB(B1, 0, 1); PG8_SCHED; PG8_LDA(At, 0, 0); PG8_STAGE(PG8_SA(1, 1), a1 + hA, voffA);
            PG8_WAIT_V(8); PG8_WAIT_L(0); PG8_BAR; PG8_MMA(0, 0, At, B0); PG8_MMA(0, 1, At, B1); PG8_BAR; PG8_SCHED;
            PG8_LDA(At, 0, 1); PG8_STAGE(PG8_SB(0, 0), b2, voffB); PG8_STAGE(PG8_SB(0, 1), b2 + hB, voffB); PG8_STAGE(PG8_SA(0, 0), a2, voffA);
            PG8_WAIT_V(8); PG8_WAIT_L(0); PG8_BAR; PG8_MMA(1, 0, At, B0); PG8_MMA(1, 1, At, B1); PG8_BAR; PG8_SCHED;
            PG8_LDB(B0, 1, 0); PG8_LDB(B1, 1, 1); PG8_SCHED; PG8_LDA(At, 1, 0); PG8_STAGE(PG8_SA(0, 1), a2 + hA, voffA);
            PG8_WAIT_V(8); PG8_WAIT_L(0); PG8_BAR; PG8_MMA(0, 0, At, B0); PG8_MMA(0, 1, At, B1); PG8_BAR; PG8_SCHED;
            PG8_LDA(At, 1, 1); PG8_STAGE(PG8_SB(1, 0), b3, voffB); PG8_STAGE(PG8_SB(1, 1), b3 + hB, voffB); PG8_STAGE(PG8_SA(1, 0), a3, voffA);
            PG8_WAIT_V(8); PG8_WAIT_L(0); PG8_BAR; PG8_MMA(1, 0, At, B0); PG8_MMA(1, 1, At, B1); PG8_BAR; PG8_SCHED;
        }
        if constexpr (ALIGN_EPI) { if (wr == 0) PG8_BAR; }
        bool zero = false;
        if (!AFTER_DRAIN || has_next) zero = E(acc, cur, wr, wc, fr, fq);
        if (!has_next) break;
        if (zero) {
#pragma unroll
            for (int a = 0; a < 2; ++a)
#pragma unroll
                for (int b = 0; b < 2; ++b)
#pragma unroll
                    for (int m = 0; m < 4; ++m)
#pragma unroll
                        for (int n = 0; n < 2; ++n) acc[a][b][m][n] = (f32x4){0.f, 0.f, 0.f, 0.f};
        }
        cur = nxt; cA = nA; cB = nB; ++ui;
        if constexpr (ALIGN_EPI) { if (wr == 1) PG8_BAR; }
    }
    PG8_WAIT_V(0);
    if constexpr (!ALIGN_EPI) { if (wr == 0) PG8_BAR; }
    PG8_BAR;
    if constexpr (AFTER_DRAIN) E.fused(acc, cur, wr, wc, fr, fq, lds);
#undef PG8_SA
#undef PG8_SB
#undef PG8_STAGE
#undef PG8_LDA
#undef PG8_LDB
#undef PG8_MMA
#undef PG8_WAIT_V
#undef PG8_WAIT_L
#undef PG8_BAR
#undef PG8_SCHED
}
}
using pg8::UD;

struct EpiP1 {
    static constexpr bool PERM = true;
    bf16_t* O; int ldc;
    __device__ __forceinline__ bool operator()(const f32x4 (&acc)[2][2][4][2], const UD& u, int wr, int wc, int fr, int fq) const {
        const int row0 = u.pm * 256 + wr * 64 + fr, col0 = u.pn * 256 + wc * 32 + 8 * fq;
        const __amdgpu_buffer_rsrc_t rs = __builtin_amdgcn_make_buffer_rsrc((void*)O, 0, 0x7fffffff, 0x00020000);
        const int voff = (row0 * ldc + col0) * 2;
#pragma unroll
        for (int ai = 0; ai < 2; ++ai)
#pragma unroll
            for (int m = 0; m < 4; ++m) {
#pragma unroll
                for (int bj = 0; bj < 2; ++bj) { const f32x4 v0 = acc[ai][bj][m][0], v1 = acc[ai][bj][m][1]; u32x4 w;
                    w.x = cvt_pk_bf16(v0[0], v0[1]); w.y = cvt_pk_bf16(v0[2], v0[3]); w.z = cvt_pk_bf16(v1[0], v1[1]); w.w = cvt_pk_bf16(v1[2], v1[3]);
                    __builtin_amdgcn_raw_buffer_store_b128(w, rs, voff, ((ai * 128 + m * 16) * ldc + bj * 128) * 2, 16); } }
        return true;
    }
};
struct SchedP1 {
    const char* A; const char* W; int c;
    __device__ __forceinline__ bool next(int i, UD& u) const {
        if (i >= 5) return false;
        const int xcd = c & 7, j = c >> 3, idx = i * 32 + j, pn = idx >> 3, pm = xcd * 8 + (idx & 7);
        u.A = A + (size_t)pm * 256 * 2048; u.B = W + (size_t)pn * 256 * 2048; u.nt = 16; u.kind = 0; u.pm = pm; u.pn = pn; u.aux = 0; return true;
    }
};
struct SchedKV {
    const char* memb; const char* wkv; int c;
    __device__ __forceinline__ bool next(int i, UD& u) const {
        if (i >= 1 || c >= 16) return false;
        const int lay = c >> 3, pm = (c & 7) >> 2, pn = c & 3;
        u.A = memb + (size_t)pm * 256 * 2048; u.B = wkv + (size_t)lay * 2 * MiB + (size_t)pn * 256 * 2048; u.nt = 16; u.kind = 1; u.pm = pm; u.pn = pn; u.aux = lay; return true;
    }
};
struct EpiP3G {
    static constexpr bool PERM = true;
    unsigned char* gs;
    __device__ __forceinline__ bool operator()(const f32x4 (&acc)[2][2][4][2], const UD& u, int wr, int wc, int fr, int fq) const {
        unsigned char* t = gs + (size_t)u.aux * 131072; const unsigned lo16 = (unsigned)tid_() * 16u;
#pragma unroll
        for (int ai = 0; ai < 2; ++ai)
#pragma unroll
            for (int bj = 0; bj < 2; ++bj)
#pragma unroll
                for (int m = 0; m < 4; ++m) { const int ci = (ai * 2 + bj) * 4 + m; float g[8];
#pragma unroll
                    for (int e = 0; e < 8; ++e) g[e] = fminf(1.0f + __expf(-acc[ai][bj][m][e >> 2][e & 3]), 1e9f);
                    u32x4 w; w.x = cvt_pk_bf16(g[0], g[1]); w.y = cvt_pk_bf16(g[2], g[3]); w.z = cvt_pk_bf16(g[4], g[5]); w.w = cvt_pk_bf16(g[6], g[7]);
                    *(u32x4*)(t + ci * 8192 + lo16) = w; }
        return true;
    }
};
struct SchedP3G {
    const char* xn; const char* wg; int c;
    __device__ __forceinline__ bool next(int i, UD& u) const {
        if (i >= 4) return false;
        const int pm = 8 * (c & 7) + ((c >> 3) >> 2), pn = (c >> 3) & 3; u.pm = pm; u.pn = pn;
        u.A = xn + (size_t)pm * 256 * 2048; u.B = wg + (size_t)(i * 1024 + pn * 256) * 2048; u.nt = 16; u.kind = 2; u.aux = i; return true;
    }
};
struct EpiP3B {
    static constexpr bool PERM = true;
    unsigned char* gs; bf16_t* merged;
    __device__ __forceinline__ bool operator()(f32x4 (&acc)[2][2][4][2], const UD& u, int wr, int wc, int fr, int fq) const {
        const int n = u.aux; const bool fin = (n == 3);
        const __amdgpu_buffer_rsrc_t rs = __builtin_amdgcn_make_buffer_rsrc((void*)gs, 0, 0x7fffffff, 0x00020000);
        const int s0 = n * 131072, s1 = (fin ? 3 : n + 1) * 131072; const int lo16 = (int)tid_() * 16;
#pragma unroll
        for (int ai = 0; ai < 2; ++ai)
#pragma unroll
            for (int bj = 0; bj < 2; ++bj)
#pragma unroll
                for (int m = 0; m < 4; ++m) { const int ci = (ai * 2 + bj) * 4 + m;
                    const u32x4 ga = __builtin_amdgcn_raw_buffer_load_b128(rs, lo16, s0 + ci * 8192, 0);
                    u32x4 gb = __builtin_amdgcn_raw_buffer_load_b128(rs, lo16, s1 + ci * 8192, 0);
                    if (fin) gb = (u32x4){0x3f803f80u, 0x3f803f80u, 0x3f803f80u, 0x3f803f80u};
                    f32x4 v0 = acc[ai][bj][m][0], v1 = acc[ai][bj][m][1];
                    v0[0] *= bf_lo(gb.x) * rcp_(bf_lo(ga.x)); v0[1] *= bf_hi(gb.x) * rcp_(bf_hi(ga.x));
                    v0[2] *= bf_lo(gb.y) * rcp_(bf_lo(ga.y)); v0[3] *= bf_hi(gb.y) * rcp_(bf_hi(ga.y));
                    v1[0] *= bf_lo(gb.z) * rcp_(bf_lo(ga.z)); v1[1] *= bf_hi(gb.z) * rcp_(bf_hi(ga.z));
                    v1[2] *= bf_lo(gb.w) * rcp_(bf_lo(ga.w)); v1[3] *= bf_hi(gb.w) * rcp_(bf_hi(ga.w));
                    acc[ai][bj][m][0] = v0; acc[ai][bj][m][1] = v1; }
        if (!fin) return false;
        const int row0 = wr * 64 + fr, col0 = wc * 32 + 8 * fq;
#pragma unroll
        for (int ai = 0; ai < 2; ++ai)
#pragma unroll
            for (int m = 0; m < 4; ++m) {
#pragma unroll
                for (int bj = 0; bj < 2; ++bj) { const f32x4 v0 = acc[ai][bj][m][0], v1 = acc[ai][bj][m][1]; u32x4 w;
                    w.x = cvt_pk_bf16(v0[0], v0[1]); w.y = cvt_pk_bf16(v0[2], v0[3]); w.z = cvt_pk_bf16(v1[0], v1[1]); w.w = cvt_pk_bf16(v1[2], v1[3]);
                    __builtin_amdgcn_raw_buffer_store_b128(w, rs, (row0 * 256 + col0) * 2, ((ai * 128 + m * 16) * 256 + bj * 128) * 2, 16); } }
        return true;
    }
};
struct SchedP3B {
    const char* y; const char* wb; int c;
    __device__ __forceinline__ bool next(int i, UD& u) const {
        if (i >= 4) return false;
        const int pm = 8 * (c & 7) + ((c >> 3) >> 2), pn = (c >> 3) & 3; u.pm = pm; u.pn = pn;
        u.A = y + (size_t)(i >> 1) * 32 * MiB + (size_t)pm * 256 * 2048 + (size_t)(i & 1) * 1024; u.B = wb + (size_t)i * 2 * MiB + (size_t)pn * 256 * 2048; u.nt = 8; u.kind = 3; u.aux = i; return true;
    }
};
struct EpiP4 {
    static constexpr bool PERM = false;
    const float* xres; float* out; bf16_t* xn; const float* gam; const float* bet; float* stats; unsigned* cnt; unsigned* bar;
    __device__ __forceinline__ bool operator()(const f32x4 (&acc)[2][2][4][2], const UD& u, int wr, int wc, int fr, int fq) const { return false; }
    __device__ __forceinline__ void fused(f32x4 (&acc)[2][2][4][2], const UD& u, int wr, int wc, int fr, int fq, LAS unsigned char* lds) const {
        const int tid = tid_(), lane = tid & 63;
        LAS float* PS = (LAS float*)lds;
        LAS float* RS = (LAS float*)(lds + 8192);
        const int row0 = u.pm * 256 + wr * 64 + fr, col0 = u.pn * 256 + wc * 32 + 4 * fq;
#pragma unroll
        for (int ai = 0; ai < 2; ++ai)
#pragma unroll
            for (int m = 0; m < 4; ++m) { const unsigned off = (unsigned)((row0 + ai * 128 + m * 16) * DM + col0); float sm = 0.f, sq = 0.f;
#pragma unroll
                for (int bj = 0; bj < 2; ++bj)
#pragma unroll
                    for (int n = 0; n < 2; ++n) { const f32x4 xv = *(const f32x4*)(xres + (off + (unsigned)(bj * 128 + n * 16)));
                        const f32x4 v = xv * DN_ALPHA + acc[ai][bj][m][n]; acc[ai][bj][m][n] = v;
                        sm += (v[0] + v[1]) + (v[2] + v[3]); sq += (v[0] * v[0] + v[1] * v[1]) + (v[2] * v[2] + v[3] * v[3]); }
                sm += bperm((lane ^ 16) << 2, sm); sm += bperm((lane ^ 32) << 2, sm); sq += bperm((lane ^ 16) << 2, sq); sq += bperm((lane ^ 32) << 2, sq);
                if (fq == 0) { const int rl = ai * 128 + wr * 64 + m * 16 + fr; PS[(rl * 4 + wc) * 2] = sm; PS[(rl * 4 + wc) * 2 + 1] = sq; }
                if (m & 1) asm volatile("" ::: "memory"); }
        __syncthreads();
        if (tid < 256) { const f32x4 p0 = *(const LAS f32x4*)(PS + tid * 8), p1 = *(const LAS f32x4*)(PS + tid * 8 + 4);
            float* st = stats + ((size_t)(u.pm * 256 + tid) * 4 + u.pn) * 2; const float s_ = (p0[0] + p0[2]) + (p1[0] + p1[2]), q_ = (p0[1] + p0[3]) + (p1[1] + p1[3]);
            __hip_atomic_store((unsigned long long*)st, ((unsigned long long)__float_as_uint(q_) << 32) | __float_as_uint(s_), __ATOMIC_RELAXED, __HIP_MEMORY_SCOPE_AGENT); }
        flag_arrive_wt(cnt);
        flag_wait_nf(cnt, 4u, bar);
        if (tid < 256) { const unsigned long long* st = (const unsigned long long*)(stats + (size_t)(u.pm * 256 + tid) * 8);
            float ssum = 0.f, qsum = 0.f;
#pragma unroll
            for (int k = 0; k < 4; ++k) { const unsigned long long w_ = __hip_atomic_load(st + k, __ATOMIC_RELAXED, __HIP_MEMORY_SCOPE_AGENT); ssum += __uint_as_float((unsigned)w_); qsum += __uint_as_float((unsigned)(w_ >> 32)); }
            const float mean = ssum * (1.0f / DM); const float var = qsum * (1.0f / DM) - mean * mean;
            RS[tid * 2] = mean; RS[tid * 2 + 1] = 1.0f / sqrtf(fmaxf(var, 0.f) + LN_EPS); }
        __syncthreads();
#pragma unroll
        for (int bj = 0; bj < 2; ++bj)
#pragma unroll
            for (int n = 0; n < 2; ++n) { const int cc = col0 + bj * 128 + n * 16; const f32x4 gv = *(const f32x4*)(gam + cc), bv = *(const f32x4*)(bet + cc);
#pragma unroll
                for (int ai = 0; ai < 2; ++ai)
#pragma unroll
                    for (int m = 0; m < 4; ++m) { const int rl = ai * 128 + wr * 64 + m * 16 + fr; const float mean = RS[rl * 2], rstd = RS[rl * 2 + 1];
                        const unsigned off = (unsigned)((u.pm * 256 + rl) * DM + cc);
                        const f32x4 y = (acc[ai][bj][m][n] - mean) * rstd * gv + bv; st_wt16(mk_rsrc(out), (int)(off * 4u), __builtin_bit_cast(u32x4, y));
                        if (xn) { u32x2 pk; pk.x = cvt_pk_bf16(y[0], y[1]); pk.y = cvt_pk_bf16(y[2], y[3]); st_wt8(mk_rsrc(xn), (int)(off * 2u), pk); } } }
    }
};
struct SchedP4 {
    const char* gscr; const char* wo; int c;
    __device__ __forceinline__ bool next(int i, UD& u) const {
        if (i >= 4) return false;
        const int pm = 8 * (c & 7) + ((c >> 3) >> 2), pn = (c >> 3) & 3; u.pm = pm; u.pn = pn;
        const int owner = (pm >> 3) + 8 * (((pm & 7) << 2) + i);
        u.A = gscr + (size_t)owner * 4 * 131072; u.B = wo + (size_t)pn * 256 * 2048 + (size_t)i * 512; u.nt = 4; u.kind = 4; u.aux = i; return true;
    }
};

__device__ __forceinline__ unsigned f2bf(float f) { unsigned u = __builtin_bit_cast(unsigned, f); return (u + 0x7fffu + ((u >> 16) & 1u)) >> 16; }
__device__ __forceinline__ unsigned pk2(float lo, float hi) { return f2bf(lo) | (f2bf(hi) << 16); }
struct TItem { const float* W; bf16_t* WT; int N, pitch, item; };
__device__ __forceinline__ void tr_load(const TItem& t, const int lane, f32x4 (&tv)[8]) {
    const int nblk = t.N / 32, kb = t.item / nblk, nb = t.item % nblk, k0 = 64 * kb, n0 = 32 * nb, r8 = lane >> 3, q4 = (lane & 7) * 4;
#pragma unroll
    for (int i = 0; i < 8; ++i) tv[i] = __builtin_nontemporal_load((const f32x4*)(t.W + (size_t)(k0 + 8 * i + r8) * t.N + n0 + q4));
}
__device__ __forceinline__ void tr_finish(const TItem& t, const int lane, const f32x4 (&tv)[8], LAS float* scr) {
    const int nblk = t.N / 32, kb = t.item / nblk, nb = t.item % nblk, k0 = 64 * kb, n0 = 32 * nb, r8 = lane >> 3, q4 = (lane & 7) * 4;
#pragma unroll
    for (int i = 0; i < 8; ++i) { LAS float* d = scr + (8 * i + r8) * 33 + q4; d[0] = tv[i][0]; d[1] = tv[i][1]; d[2] = tv[i][2]; d[3] = tv[i][3]; }
    LDS_WAIT();
    const int c = lane & 7;
#pragma unroll
    for (int j = 0; j < 4; ++j) { const int n = (lane >> 3) + 8 * j; const LAS float* sp = scr + (8 * c) * 33 + n;
        u32x4 o; o.x = pk2(sp[0 * 33], sp[1 * 33]); o.y = pk2(sp[2 * 33], sp[3 * 33]); o.z = pk2(sp[4 * 33], sp[5 * 33]); o.w = pk2(sp[6 * 33], sp[7 * 33]);
        *(u32x4*)(t.WT + (size_t)(n0 + n) * t.pitch + k0 + 8 * c) = o; }
    LDS_WAIT();
}

struct Args {
    const float* x; const float* mem; const float* w_in; const float* w_pool; const float* pool_scale; const float* conv_w; const float* conv_b;
    const float* w_rg; const float* b_rg; const float* w_ig; const float* b_ig; const float* lru_L; const float* w_mem_kv; const float* w_branch;
    const float* w_out; const float* ln_g; const float* ln_b; float* out; unsigned char* ws;
};

__device__ __forceinline__ void sb_unit(LAS unsigned char* lds, const bf16_t* __restrict__ P, bf16_t* __restrict__ Y01, const int h, const int i) {
    const int tid = tid_(), lane = tid & 63, w = __builtin_amdgcn_readfirstlane(tid >> 6), ql = lane & 15, quad = lane >> 4;
    LAS bf16_t* Ks = (LAS bf16_t*)lds;
    LAS bf16_t* Vs = Ks + 128 * 136;
    const LAS bf16_t* vtr = Vs + (quad * 4 + (ql >> 2)) * 144 + 4 * (ql & 3);
    const int qloc = w * 16 + ql; const size_t qrow = (size_t)i * 128 + qloc;
    const float scale2 = 0.08838834764831845f * 1.4426950408889634f;
    bf16x8 qf[4];
#pragma unroll
    for (int ks = 0; ks < 4; ++ks) qf[ks] = *(const bf16x8*)(P + qrow * PW + h * 128 + ks * 32 + quad * 8);
    f32x4 o[8]; u32x2 gq[8];
#pragma unroll
    for (int d = 0; d < 8; ++d) { o[d] = (f32x4){0.f, 0.f, 0.f, 0.f}; gq[d] = *(const u32x2*)(P + qrow * PW + 1536 + h * 128 + d * 16 + quad * 4); }
    float later = 0.f; int wdone = 0;
    u32x4 kreg[4], vreg[4];
#define SB_LOAD(JJ) do { _Pragma("unroll") for (int q_ = 0; q_ < 4; ++q_) { const int c_ = tid + q_ * 512, r_ = c_ >> 4, cc_ = c_ & 15; \
            const bf16_t* kp_ = P + ((size_t)(JJ) * 128 + r_) * PW + 512 + h * 128 + cc_ * 8; kreg[q_] = *(const u32x4*)kp_; vreg[q_] = *(const u32x4*)(kp_ + 512); } } while (0)
    SB_LOAD(i);
    __syncthreads();
    for (int j = i; ; --j) {
#pragma unroll
        for (int q = 0; q < 4; ++q) { const int c = tid + q * 512, r = c >> 4, cc = c & 15; *(LAS u32x4*)(Ks + r * 136 + cc * 8) = kreg[q]; *(LAS u32x4*)(Vs + r * 144 + cc * 8) = vreg[q]; }
        __syncthreads();
        if (j > 0) SB_LOAD(j - 1);
        if (!wdone) {
            const bool diag = (j == i);
            float R = later;
#pragma unroll
            for (int p = 3; p >= 0; --p) {
                if (!wdone && !(diag && 2 * p > w)) {
                    f32x4 s0 = (f32x4){0.f, 0.f, 0.f, 0.f}, s1 = (f32x4){0.f, 0.f, 0.f, 0.f};
#pragma unroll
                    for (int ks = 0; ks < 4; ++ks) {
                        const bf16x8 a0 = *(const LAS bf16x8*)(Ks + ((2 * p) * 16 + ql) * 136 + ks * 32 + quad * 8);
                        const bf16x8 a1 = *(const LAS bf16x8*)(Ks + ((2 * p + 1) * 16 + ql) * 136 + ks * 32 + quad * 8);
                        s0 = __builtin_amdgcn_mfma_f32_16x16x32_bf16(a0, qf[ks], s0, 0, 0, 0); s1 = __builtin_amdgcn_mfma_f32_16x16x32_bf16(a1, qf[ks], s1, 0, 0, 0); }
                    unsigned pw[4];
#pragma unroll
                    for (int hh = 1; hh >= 0; --hh) { const int kt = 2 * p + hh; const f32x4 sv = hh ? s1 : s0;
                        float l1[4], ls[4]; bool vd[4];
#pragma unroll
                        for (int e = 0; e < 4; ++e) { const float z = sv[e] * scale2; const float t = __builtin_amdgcn_logf(1.0f + __builtin_amdgcn_exp2f(-fabsf(z)));
                            vd[e] = !diag || (kt * 16 + quad * 4 + e < qloc);
                            const float nsp = -(fmaxf(z, 0.f) + t);
                            l1[e] = vd[e] ? nsp : 0.f; ls[e] = z + nsp; }
                        const float sl = (l1[0] + l1[1]) + (l1[2] + l1[3]);
                        const float x1 = bperm((lane ^ 16) << 2, sl); const float s1 = sl + x1;
                        const float y = bperm((lane ^ 32) << 2, s1);
                        const float gt = (((quad & 1) == 0) ? x1 : 0.f) + (((quad & 2) == 0) ? y : 0.f);
                        const float T = s1 + y;
                        const float w3 = R + gt, w2 = w3 + l1[3], w1 = w2 + l1[2], w0 = w1 + l1[1];
                        const float p0 = vd[0] ? __builtin_amdgcn_exp2f(ls[0] + w0) : 0.f, p1 = vd[1] ? __builtin_amdgcn_exp2f(ls[1] + w1) : 0.f;
                        const float p2 = vd[2] ? __builtin_amdgcn_exp2f(ls[2] + w2) : 0.f, p3 = vd[3] ? __builtin_amdgcn_exp2f(ls[3] + w3) : 0.f;
                        pw[hh * 2] = cvt_pk_bf16(p0, p1); pw[hh * 2 + 1] = cvt_pk_bf16(p2, p3);
                        R += T; }
                    const u32x4 pv = (u32x4){pw[0], pw[1], pw[2], pw[3]};
#pragma unroll
                    for (int dt = 0; dt < 8; ++dt) {
                        const u32x2 lo = lds_tr16(vtr + (2 * p) * 16 * 144 + dt * 16);
                        const u32x2 hi = lds_tr16(vtr + (2 * p + 1) * 16 * 144 + dt * 16);
                        const u32x4 av = (u32x4){lo.x, lo.y, hi.x, hi.y};
                        o[dt] = __builtin_amdgcn_mfma_f32_16x16x32_bf16(__builtin_bit_cast(bf16x8, av), __builtin_bit_cast(bf16x8, pv), o[dt], 0, 0, 0); }
                    wdone = __all(R < -150.05f) ? 1 : 0;
                }
            }
            later = R;
        }
        if (__syncthreads_and(wdone) || j == 0) break;
    }
    u32x2 rr[8];
#pragma unroll
    for (int dt = 0; dt < 8; ++dt) { const u32x2 g = gq[dt];
        rr[dt].x = cvt_pk_bf16(o[dt][0] * siluf_(bf_lo(g.x)), o[dt][1] * siluf_(bf_hi(g.x))); rr[dt].y = cvt_pk_bf16(o[dt][2] * siluf_(bf_lo(g.y)), o[dt][3] * siluf_(bf_hi(g.y))); }
    store_row_tiles(mk_rsrc(Y01), (int)((qrow * 1024 + h * 128) * 2), rr, lane, quad);
}

__device__ __forceinline__ void xa_stage(LAS unsigned char* lds, const bf16_t* __restrict__ KV  , const int h) {
    const int tid = tid_();
    LAS bf16_t* Kms = (LAS bf16_t*)lds;
    LAS bf16_t* Vm = Kms + 256 * 136;
    for (int c = tid; c < 4096; c += 512) { const int r = c >> 4, cc = c & 15;
        const bf16_t* kp = KV + (size_t)r * 1024 + h * 128 + cc * 8;
        *(LAS u32x4*)(Kms + r * 136 + cc * 8) = *(const u32x4*)kp; *(LAS u32x4*)(Vm + r * 144 + cc * 8) = *(const u32x4*)(kp + 512); }
}
__device__ __forceinline__ void xa_tile(LAS unsigned char* lds, const bf16_t* __restrict__ P, bf16_t* __restrict__ Y23, const int h, const int tile) {
    const int tid = tid_(), lane = tid & 63, w = tid >> 6, ql = lane & 15, quad = lane >> 4;
    const LAS bf16_t* Kms = (const LAS bf16_t*)lds;
    const LAS bf16_t* vtr = Kms + 256 * 136 + (quad * 4 + (ql >> 2)) * 144 + 4 * (ql & 3);
    const size_t qrow = (size_t)tile * 128 + w * 16 + ql;
    const float scale = 0.08838834764831845f;
    bf16x8 qf[4];
#pragma unroll
    for (int ks = 0; ks < 4; ++ks) qf[ks] = *(const bf16x8*)(P + qrow * PW + 4096 + h * 128 + ks * 32 + quad * 8);
    f32x4 s[16];
#pragma unroll
    for (int kt = 0; kt < 16; ++kt) { s[kt] = (f32x4){0.f, 0.f, 0.f, 0.f};
#pragma unroll
        for (int ks = 0; ks < 4; ++ks) { const bf16x8 a = *(const LAS bf16x8*)(Kms + (kt * 16 + ql) * 136 + ks * 32 + quad * 8);
            s[kt] = __builtin_amdgcn_mfma_f32_16x16x32_bf16(a, qf[ks], s[kt], 0, 0, 0); } }
    float m = -3.0e38f;
#pragma unroll
    for (int kt = 0; kt < 16; ++kt)
#pragma unroll
        for (int e = 0; e < 4; ++e) m = fmaxf(m, s[kt][e]);
    m = fmaxf(m, bperm((lane ^ (16)) << 2, m)); m = fmaxf(m, bperm((lane ^ (32)) << 2, m));
    float sum = 0.f; unsigned pw[32];
#pragma unroll
    for (int kt = 0; kt < 16; ++kt) { float p[4];
#pragma unroll
        for (int e = 0; e < 4; ++e) { p[e] = __builtin_amdgcn_exp2f((s[kt][e] - m) * (scale * 1.4426950408889634f)); sum += p[e]; }
        pw[kt * 2] = cvt_pk_bf16(p[0], p[1]); pw[kt * 2 + 1] = cvt_pk_bf16(p[2], p[3]); }
    sum += bperm((lane ^ (16)) << 2, sum); sum += bperm((lane ^ (32)) << 2, sum);
    const float inv = 1.0f / sum;
    f32x4 o[8];
#pragma unroll
    for (int dt = 0; dt < 8; ++dt) { o[dt] = (f32x4){0.f, 0.f, 0.f, 0.f};
#pragma unroll
        for (int ks = 0; ks < 8; ++ks) {
            const u32x2 lo = lds_tr16(vtr + (2 * ks) * 16 * 144 + dt * 16);
            const u32x2 hi = lds_tr16(vtr + (2 * ks + 1) * 16 * 144 + dt * 16);
            const u32x4 av = (u32x4){lo.x, lo.y, hi.x, hi.y};
            const u32x4 pv = (u32x4){pw[4 * ks], pw[4 * ks + 1], pw[4 * ks + 2], pw[4 * ks + 3]};
            o[dt] = __builtin_amdgcn_mfma_f32_16x16x32_bf16(__builtin_bit_cast(bf16x8, av), __builtin_bit_cast(bf16x8, pv), o[dt], 0, 0, 0); } }
    u32x2 rr[8];
#pragma unroll
    for (int dt = 0; dt < 8; ++dt) { const int d = dt * 16 + quad * 4;
        const u32x2 g = *(const u32x2*)(P + qrow * PW + 4608 + h * 128 + d);
        rr[dt].x = cvt_pk_bf16(o[dt][0] * inv * siluf_(bf_lo(g.x)), o[dt][1] * inv * siluf_(bf_hi(g.x)));
        rr[dt].y = cvt_pk_bf16(o[dt][2] * inv * siluf_(bf_lo(g.y)), o[dt][3] * inv * siluf_(bf_hi(g.y))); }
    store_row_tiles(mk_rsrc(Y23), (int)((qrow * 1024 + 512 + h * 128) * 2), rr, lane, quad);
}

__device__ __forceinline__ void pool_stage(LAS unsigned char* lds, const bf16_t* __restrict__ Wp  ) {
    LAS bf16_t* Ws = (LAS bf16_t*)lds;
    for (int c = tid_(); c < 2048; c += 512) { const int r = c >> 4, cc = c & 15; *(LAS u32x4*)(Ws + r * 136 + cc * 8) = *(const u32x4*)(Wp + r * 128 + cc * 8); }
}
template <int WIN>
__device__ __forceinline__ void pool_tile_w(LAS unsigned char* lds, const bf16_t* __restrict__ P, bf16_t* __restrict__ Y01, const float* __restrict__ pscale, const int g, const int tile) {
    const int tid = tid_(), lane = tid & 63, w = tid >> 6, ql = lane & 15, quad = lane >> 4;
    const LAS bf16_t* Ws = (const LAS bf16_t*)lds;
    LAS bf16_t* U = (LAS bf16_t*)(lds + 34816);
    u32x2 gq[8];
#pragma unroll
    for (int jt = 0; jt < 8; ++jt) gq[jt] = *(const u32x2*)(P + (size_t)(tile * 128 + w * 16 + ql) * PW + 2560 + g * 128 + jt * 16 + quad * 4);
    __syncthreads();
    for (int c = tid; c < 143 * 16; c += 512) { const int r = c >> 4, cc = c & 15; const int grow = tile * 128 - 15 + r;
        u32x4 v = (u32x4){0u, 0u, 0u, 0u};
        if (grow >= 0) v = *(const u32x4*)(P + (size_t)grow * PW + 2048 + g * 128 + cc * 8);
        *(LAS u32x4*)(U + r * 136 + cc * 8) = v; }
    __syncthreads();
    const int pos = tile * 128 + w * 16 + ql, lrow = 15 + w * 16 + ql;
    const int cnt = (pos + 1 < WIN) ? pos + 1 : WIN; const float rc = rcp_((float)cnt);
    bf16x8 bfm[4];
#pragma unroll
    for (int ks = 0; ks < 4; ++ks) {
        const LAS bf16_t* up = U + lrow * 136 + ks * 32 + quad * 8;
        const u32x4 c0 = *(const LAS u32x4*)up;
        const float a[8] = {bf_lo(c0.x), bf_hi(c0.x), bf_lo(c0.y), bf_hi(c0.y), bf_lo(c0.z), bf_hi(c0.z), bf_lo(c0.w), bf_hi(c0.w)};
        float sm[8];
#pragma unroll
        for (int e = 0; e < 8; ++e) sm[e] = a[e];
#pragma unroll
        for (int t = 1; t < WIN; ++t) { const u32x4 c1 = *(const LAS u32x4*)(up - t * 136);
            sm[0] += bf_lo(c1.x); sm[1] += bf_hi(c1.x); sm[2] += bf_lo(c1.y); sm[3] += bf_hi(c1.y); sm[4] += bf_lo(c1.z); sm[5] += bf_hi(c1.z); sm[6] += bf_lo(c1.w); sm[7] += bf_hi(c1.w); }
        u32x4 pk; pk.x = cvt_pk_bf16(sm[0] * rc - a[0], sm[1] * rc - a[1]); pk.y = cvt_pk_bf16(sm[2] * rc - a[2], sm[3] * rc - a[3]);
        pk.z = cvt_pk_bf16(sm[4] * rc - a[4], sm[5] * rc - a[5]); pk.w = cvt_pk_bf16(sm[6] * rc - a[6], sm[7] * rc - a[7]);
        bfm[ks] = __builtin_bit_cast(bf16x8, pk);
    }
    u32x2 rr[8];
#pragma unroll
    for (int jt = 0; jt < 8; ++jt) { f32x4 acc = (f32x4){0.f, 0.f, 0.f, 0.f};
#pragma unroll
        for (int ks = 0; ks < 4; ++ks) { const bf16x8 a = *(const LAS bf16x8*)(Ws + (jt * 16 + ql) * 136 + ks * 32 + quad * 8);
            acc = __builtin_amdgcn_mfma_f32_16x16x32_bf16(a, bfm[ks], acc, 0, 0, 0); }
        const int j = g * 128 + jt * 16 + quad * 4;
        const f32x4 ps = *(const f32x4*)(pscale + j);
        const u32x2 gg = gq[jt];
        rr[jt].x = cvt_pk_bf16(acc[0] * ps[0] * siluf_(bf_lo(gg.x)), acc[1] * ps[1] * siluf_(bf_hi(gg.x)));
        rr[jt].y = cvt_pk_bf16(acc[2] * ps[2] * siluf_(bf_lo(gg.y)), acc[3] * ps[3] * siluf_(bf_hi(gg.y))); }
    store_row_tiles(mk_rsrc(Y01), (pos * 1024 + 512 + g * 128) * 2, rr, lane, quad);
}
__device__ __forceinline__ void pool_tile(LAS unsigned char* lds, const bf16_t* __restrict__ P, bf16_t* __restrict__ Y01, const float* __restrict__ pscale, const int g, const int tile) {
    if (g == 0) pool_tile_w<2>(lds, P, Y01, pscale, g, tile);
    else if (g == 1) pool_tile_w<4>(lds, P, Y01, pscale, g, tile);
    else if (g == 2) pool_tile_w<8>(lds, P, Y01, pscale, g, tile);
    else pool_tile_w<16>(lds, P, Y01, pscale, g, tile);
}

#define XB_TMO      128
#define XB_XCNT(j)  (256  + 64 * (j))
#define XB_XSUB(j)  (1280 + 64 * (j))
#define XB_XGEN(j)  (2304 + 64 * (j))
#define XB_TOP      3328
#define XB_TOPGEN   3392
#define XCD_BAR_WORDS 3456
#define XB_SPIN_CAP (1u << 22)
__device__ __forceinline__ unsigned xb_ld(unsigned* p)              { return __hip_atomic_load(p, __ATOMIC_RELAXED, __HIP_MEMORY_SCOPE_AGENT); }
__device__ __forceinline__ unsigned xb_add(unsigned* p, unsigned v) { return __hip_atomic_fetch_add(p, v, __ATOMIC_RELAXED, __HIP_MEMORY_SCOPE_AGENT); }
__device__ __forceinline__ unsigned xb_xcc_id() { return (unsigned)__builtin_amdgcn_s_getreg((3 << 11) | 20) & 0xFu; }
#define XB_SPIN(cond, bar) do { unsigned _sp = 0; while (cond) { __builtin_amdgcn_s_sleep(1); \
    if ((++_sp & 255u) == 0u) { if (xb_ld(&(bar)[XB_TMO])) break; if (_sp > XB_SPIN_CAP) { atomicAdd(&(bar)[XB_TMO], 1u); break; } } } } while (0)
__device__ __forceinline__ void xcd_barrier_complete(unsigned* bar, unsigned x, unsigned& nloc, unsigned& nx) {
    const unsigned G = gridDim.x * gridDim.y * gridDim.z;
    unsigned sum, cnt, mine, sp = 0u;
    for (;;) {
        sum = 0u; cnt = 0u; mine = 0u;
#pragma unroll
        for (unsigned j = 0; j < 16; ++j) { const unsigned c = xb_ld(&bar[XB_XCNT(j)]); sum += c; cnt += (c > 0u) ? 1u : 0u; mine = (j == x) ? c : mine; }
        if (sum == G) break;
        __builtin_amdgcn_s_sleep(1);
        if ((++sp & 255u) == 0u) { if (xb_ld(&bar[XB_TMO])) break; if (sp > XB_SPIN_CAP) { atomicAdd(&bar[XB_TMO], 1u); break; } }
    }
    nloc = mine > 0u ? mine : 1u; nx = cnt > 0u ? cnt : 1u;
}
__device__ __forceinline__ void xcd_barrier(unsigned* bar, volatile LAS unsigned* st) {
    asm volatile("s_waitcnt vmcnt(0)" ::: "memory");
    __syncthreads();
    if (tid_() == 0) {
        const unsigned x = xb_xcc_id();
        __builtin_amdgcn_s_waitcnt(0);
        unsigned nloc = st[0], nx = st[1];
        if (nloc == 0u) { xcd_barrier_complete(bar, x, nloc, nx); st[0] = nloc; st[1] = nx; }
        const unsigned old = xb_add(&bar[XB_XSUB(x)], 1u);
        const unsigned gen = old / nloc;
        if (old + 1u == (gen + 1u) * nloc) {
            __builtin_amdgcn_fence(__ATOMIC_RELEASE, "agent");
            asm volatile("s_waitcnt vmcnt(0)" ::: "memory");
            const unsigned og = xb_add(&bar[XB_TOP], 1u);
            const unsigned tg = og / nx;
            if (og + 1u == (tg + 1u) * nx) xb_add(&bar[XB_TOPGEN], 1u);
            else XB_SPIN(xb_ld(&bar[XB_TOPGEN]) == tg, bar);
            __builtin_amdgcn_fence(__ATOMIC_ACQUIRE, "agent");
            xb_add(&bar[XB_XGEN(x)], 1u);
            asm volatile("s_waitcnt vmcnt(0)" ::: "memory");
        } else {
            XB_SPIN(xb_ld(&bar[XB_XGEN(x)]) == gen, bar);
            __builtin_amdgcn_fence(__ATOMIC_ACQUIRE, "agent");
            asm volatile("s_waitcnt vmcnt(0)" ::: "memory");
        }
    }
    __syncthreads();
}


__device__ __forceinline__ void flag_arrive(unsigned* cnt) {
    asm volatile("s_waitcnt vmcnt(0)" ::: "memory"); __syncthreads();
    if (tid_() == 0) { __builtin_amdgcn_fence(__ATOMIC_RELEASE, "agent"); asm volatile("s_waitcnt vmcnt(0)" ::: "memory"); (void)xb_add(cnt, 1u); }
}
__device__ __forceinline__ void flag_wait_nf(unsigned* cnt, unsigned target, unsigned* bar) {
    if (tid_() == 0) { XB_SPIN(xb_ld(cnt) < target, bar); }
    __syncthreads();
}
__device__ __forceinline__ float ld_agent(const float* p) { return __hip_atomic_load(p, __ATOMIC_RELAXED, __HIP_MEMORY_SCOPE_AGENT); }
__device__ __forceinline__ void flag_arrive_wt(unsigned* cnt) {
    asm volatile("s_waitcnt vmcnt(0)" ::: "memory"); __syncthreads();
    if (tid_() == 0) (void)xb_add(cnt, 1u);
}
__device__ __forceinline__ void flag_wait(unsigned* cnt, unsigned target, unsigned* bar) {
    if (tid_() == 0) { XB_SPIN(xb_ld(cnt) < target, bar); __builtin_amdgcn_fence(__ATOMIC_ACQUIRE, "agent"); asm volatile("s_waitcnt vmcnt(0)" ::: "memory"); }
    __syncthreads();
}
__device__ __forceinline__ void fold4(const float* base, const int n, const int quad, const int ql, float (&Po)[4], float (&Ho)[4]) {
    const int seg = (n + 3) >> 2, i0 = quad * seg; int i1 = i0 + seg; if (i1 > n) i1 = n;
    float Ps[4] = {1.f, 1.f, 1.f, 1.f}, Hs[4] = {0.f, 0.f, 0.f, 0.f};
#pragma unroll 4
    for (int i = i0; i < i1; ++i) {
#pragma unroll
        for (int nt = 0; nt < 4; ++nt) { const float a = ld_agent(base + (size_t)i * 1024 + nt * 16), bb = ld_agent(base + (size_t)i * 1024 + 512 + nt * 16); Hs[nt] = a * Hs[nt] + bb; Ps[nt] *= a; } }
#pragma unroll
    for (int nt = 0; nt < 4; ++nt) {
        const float P0 = bperm((ql) << 2, Ps[nt]), P1 = bperm((ql + 16) << 2, Ps[nt]), P2 = bperm((ql + 32) << 2, Ps[nt]), P3 = bperm((ql + 48) << 2, Ps[nt]);
        const float H0 = bperm((ql) << 2, Hs[nt]), H1 = bperm((ql + 16) << 2, Hs[nt]), H2 = bperm((ql + 32) << 2, Hs[nt]), H3 = bperm((ql + 48) << 2, Hs[nt]);
        Po[nt] = (P0 * P1) * (P2 * P3); Ho[nt] = ((H0 * P1 + H1) * P2 + H2) * P3 + H3; }
}

__device__ __forceinline__ void lru_stage(LAS unsigned char* lds, const float* cw, const float* cb, const float* brg, const float* big, const float* L) {
    LAS float* F = (LAS float*)lds;
    for (int i = tid_(); i < 2048; i += 512) F[i] = cw[i];
    { const int i = tid_(); F[2048 + i] = cb[i]; F[2560 + i] = brg[i]; F[3072 + i] = big[i];
      const float l = -L[i]; F[3584 + i] = fmaxf(l, 0.f) + log1pf(__expf(-fabsf(l))); }
}
template <bool FINAL>
__device__ __forceinline__ void lru_unit(LAS unsigned char* lds, const bf16_t* __restrict__ P, bf16_t* __restrict__ Y23, float* __restrict__ AGG, const float* __restrict__ GAGG,
                                         const bf16_t* __restrict__ Wrg, const bf16_t* __restrict__ Wig, unsigned char* __restrict__ cache, const int tile) {
    const int tid = tid_(), lane = tid & 63, hd = tid >> 6, ql = lane & 15, quad = lane >> 4;
    const LAS float* F = (const LAS float*)lds;
    LAS float* XC = (LAS float*)(lds + 16384 + hd * 7168);
    bf16x8 wr_[4][2], wi_[4][2];
#pragma unroll
    for (int nt = 0; nt < 4; ++nt)
#pragma unroll
        for (int ks = 0; ks < 2; ++ks) { const size_t o = (size_t)(hd * 64 + nt * 16 + ql) * 64 + ks * 32 + quad * 8;
            wr_[nt][ks] = *(const bf16x8*)(Wrg + o); wi_[nt][ks] = *(const bf16x8*)(Wig + o); }
    float hst[4] = {0.f, 0.f, 0.f, 0.f}, ptot[4] = {1.f, 1.f, 1.f, 1.f};
    if (FINAL) {
        float Pa[4], Ha[4], Pb[4], Hb[4];
        fold4(GAGG + hd * 64 + ql, tile >> 4, quad, ql, Pa, Ha);
        fold4(AGG + (size_t)(tile & ~15) * 1024 + hd * 64 + ql, tile & 15, quad, ql, Pb, Hb);
#pragma unroll
        for (int nt = 0; nt < 4; ++nt) hst[nt] = Pb[nt] * Ha[nt] + Hb[nt];
    }
    const int tk = lane >> 2, cg4 = (lane & 3) * 16, cb0 = hd * 64 + cg4;
    LAS bf16_t* UB = (LAS bf16_t*)(lds + 16384 + hd * 7168 + 4352);
    u32x4 pu[3];
    const int lrow = lane >> 3, lch = (lane & 7) * 8;
#define LRU_LOADU(T0) do { const bf16_t* ub_ = P + 3072 + hd * 64 + lch; \
        pu[0] = *(const u32x4*)(ub_ + (size_t)((T0) + lrow) * PW); pu[1] = *(const u32x4*)(ub_ + (size_t)((T0) + 8 + lrow) * PW); \
        { const int p = (T0) - 3 + lrow; pu[2] = (lane < 24 && p >= 0) ? *(const u32x4*)(ub_ + (size_t)(p < 0 ? 0 : p) * PW) : (u32x4){0u, 0u, 0u, 0u}; } } while (0)
    LRU_LOADU(tile * 64);
    for (int sub = 0; sub < 4; ++sub) {
        const int t0 = tile * 64 + sub * 16;
        {
            LDS_WAIT();
            *(LAS u32x4*)(UB + (3 + lrow) * 72 + lch) = pu[0]; *(LAS u32x4*)(UB + (11 + lrow) * 72 + lch) = pu[1];
            if (lane < 24) *(LAS u32x4*)(UB + lrow * 72 + lch) = pu[2];
            LDS_WAIT();
            if (sub < 3) LRU_LOADU(t0 + 16);
            float xc[16];
#pragma unroll
            for (int e = 0; e < 16; ++e) xc[e] = F[2048 + cb0 + e];
#pragma unroll
            for (int tap = 0; tap < 4; ++tap) {
                const u32x4 u0 = *(const LAS u32x4*)(UB + (tk + tap) * 72 + cg4), u1 = *(const LAS u32x4*)(UB + (tk + tap) * 72 + cg4 + 8);
                const float uv[16] = {bf_lo(u0.x), bf_hi(u0.x), bf_lo(u0.y), bf_hi(u0.y), bf_lo(u0.z), bf_hi(u0.z), bf_lo(u0.w), bf_hi(u0.w),
                                      bf_lo(u1.x), bf_hi(u1.x), bf_lo(u1.y), bf_hi(u1.y), bf_lo(u1.z), bf_hi(u1.z), bf_lo(u1.w), bf_hi(u1.w)};
#pragma unroll
                for (int e = 0; e < 16; ++e) xc[e] += F[tap * 512 + cb0 + e] * uv[e]; }
#pragma unroll
            for (int q = 0; q < 4; ++q) *(LAS f32x4*)(XC + tk * 68 + cg4 + q * 4) = (f32x4){xc[q * 4], xc[q * 4 + 1], xc[q * 4 + 2], xc[q * 4 + 3]};
            LDS_WAIT();
        }
        bf16x8 af[2];
#pragma unroll
        for (int ks = 0; ks < 2; ++ks) { const f32x4 a0 = *(const LAS f32x4*)(XC + ql * 68 + ks * 32 + quad * 8), a1 = *(const LAS f32x4*)(XC + ql * 68 + ks * 32 + quad * 8 + 4);
            u32x4 pk; pk.x = cvt_pk_bf16(a0[0], a0[1]); pk.y = cvt_pk_bf16(a0[2], a0[3]); pk.z = cvt_pk_bf16(a1[0], a1[1]); pk.w = cvt_pk_bf16(a1[2], a1[3]);
            af[ks] = __builtin_bit_cast(bf16x8, pk); }
#pragma unroll
        for (int nt = 0; nt < 4; ++nt) {
            f32x4 ar = (f32x4){0.f, 0.f, 0.f, 0.f}, ai = (f32x4){0.f, 0.f, 0.f, 0.f};
#pragma unroll
            for (int ks = 0; ks < 2; ++ks) { ar = __builtin_amdgcn_mfma_f32_16x16x32_bf16(af[ks], wr_[nt][ks], ar, 0, 0, 0); ai = __builtin_amdgcn_mfma_f32_16x16x32_bf16(af[ks], wi_[nt][ks], ai, 0, 0, 0); }
            const int c = hd * 64 + nt * 16 + ql;
            const float brg = F[2560 + c], big = F[3072 + c], spl = F[3584 + c];
            float av[4], bv[4]; unsigned cpk[4];
#pragma unroll
            for (int e = 0; e < 4; ++e) { const float xcv = XC[(quad * 4 + e) * 68 + nt * 16 + ql];
                const float r = sigmoidf_(ar[e] + brg), ig = sigmoidf_(ai[e] + big);
                const float la = -8.0f * r * spl; const float a = __expf(la);
                const float om = fmaxf(1.0f - a * a, 0.0f);
                const unsigned pkv = cvt_pk_bf16(la, __builtin_amdgcn_sqrtf(om) * ig * xcv); cpk[e] = pkv;
                av[e] = FINAL ? a : __expf(bf_lo(pkv)); bv[e] = bf_hi(pkv); }
            if (!FINAL) *(u32x4*)(cache + ((size_t)((sub * 4 + nt) * 512 + tid)) * 16) = (u32x4){cpk[0], cpk[1], cpk[2], cpk[3]};
            const float Pq = (av[0] * av[1]) * (av[2] * av[3]);
            const float Hq = ((bv[0] * av[1] + bv[1]) * av[2] + bv[2]) * av[3] + bv[3];
            const float P0 = bperm((ql) << 2, Pq), P1 = bperm((ql + 16) << 2, Pq), P2 = bperm((ql + 32) << 2, Pq), P3 = bperm((ql + 48) << 2, Pq);
            const float H0 = bperm((ql) << 2, Hq), H1 = bperm((ql + 16) << 2, Hq), H2 = bperm((ql + 32) << 2, Hq), H3 = bperm((ql + 48) << 2, Hq);
            const float c0 = hst[nt], c1 = P0 * c0 + H0, c2 = P1 * c1 + H1, c3 = P2 * c2 + H2;
            if (FINAL) {
                float hh = quad == 0 ? c0 : (quad == 1 ? c1 : (quad == 2 ? c2 : c3));
#pragma unroll
                for (int e = 0; e < 4; ++e) { hh = av[e] * hh + bv[e]; XC[(quad * 4 + e) * 68 + nt * 16 + ql] = hh; }
            }
            hst[nt] = P3 * c3 + H3; ptot[nt] *= (P0 * P1) * (P2 * P3);
        }
        if (FINAL) {
            LDS_WAIT();
            const size_t row = (size_t)t0 + tk;
            const bf16_t* gp = P + row * PW + 3584 + cb0; const u32x4 g0 = *(const u32x4*)gp, g1 = *(const u32x4*)(gp + 8);
            const f32x4 h0 = *(const LAS f32x4*)(XC + tk * 68 + cg4), h1 = *(const LAS f32x4*)(XC + tk * 68 + cg4 + 4), h2 = *(const LAS f32x4*)(XC + tk * 68 + cg4 + 8), h3 = *(const LAS f32x4*)(XC + tk * 68 + cg4 + 12);
            u32x4 o0, o1;
            o0.x = cvt_pk_bf16(h0[0] * siluf_(bf_lo(g0.x)), h0[1] * siluf_(bf_hi(g0.x))); o0.y = cvt_pk_bf16(h0[2] * siluf_(bf_lo(g0.y)), h0[3] * siluf_(bf_hi(g0.y)));
            o0.z = cvt_pk_bf16(h1[0] * siluf_(bf_lo(g0.z)), h1[1] * siluf_(bf_hi(g0.z))); o0.w = cvt_pk_bf16(h1[2] * siluf_(bf_lo(g0.w)), h1[3] * siluf_(bf_hi(g0.w)));
            o1.x = cvt_pk_bf16(h2[0] * siluf_(bf_lo(g1.x)), h2[1] * siluf_(bf_hi(g1.x))); o1.y = cvt_pk_bf16(h2[2] * siluf_(bf_lo(g1.y)), h2[3] * siluf_(bf_hi(g1.y)));
            o1.z = cvt_pk_bf16(h3[0] * siluf_(bf_lo(g1.z)), h3[1] * siluf_(bf_hi(g1.z))); o1.w = cvt_pk_bf16(h3[2] * siluf_(bf_lo(g1.w)), h3[3] * siluf_(bf_hi(g1.w)));
            bf16_t* yp = Y23 + row * 1024 + cb0; *(u32x4*)yp = o0; *(u32x4*)(yp + 8) = o1;
        }
    }
    if (!FINAL && quad == 0) {
#pragma unroll
        for (int nt = 0; nt < 4; ++nt) { const int c = hd * 64 + nt * 16 + ql; __hip_atomic_store(AGG + (size_t)tile * 1024 + c, ptot[nt], __ATOMIC_RELAXED, __HIP_MEMORY_SCOPE_AGENT); __hip_atomic_store(AGG + (size_t)tile * 1024 + 512 + c, hst[nt], __ATOMIC_RELAXED, __HIP_MEMORY_SCOPE_AGENT); }
    }
}


__device__ __forceinline__ void lru_final(LAS unsigned char* lds, const bf16_t* __restrict__ P, bf16_t* __restrict__ Y23, const float* __restrict__ AGG, const float* __restrict__ GAGG,
                                          const unsigned char* __restrict__ cache, const int tile) {
    const int tid = tid_(), lane = tid & 63, hd = tid >> 6, ql = lane & 15, quad = lane >> 4;
    LAS float* XC = (LAS float*)(lds + hd * 4352);
    float hst[4];
    {   float Pa[4], Ha[4], Pb[4], Hb[4];
        fold4(GAGG + hd * 64 + ql, tile >> 4, quad, ql, Pa, Ha);
        fold4(AGG + (size_t)(tile & ~15) * 1024 + hd * 64 + ql, tile & 15, quad, ql, Pb, Hb);
#pragma unroll
        for (int nt = 0; nt < 4; ++nt) hst[nt] = Pb[nt] * Ha[nt] + Hb[nt]; }
    const int tk = lane >> 2, cg4 = (lane & 3) * 16, cb0 = hd * 64 + cg4;
    u32x4 pk[4];
#pragma unroll
    for (int nt = 0; nt < 4; ++nt) pk[nt] = *(const u32x4*)(cache + ((size_t)(nt * 512 + tid)) * 16);
    for (int sub = 0; sub < 4; ++sub) {
        const int t0 = tile * 64 + sub * 16;
        const size_t row = (size_t)t0 + tk;
        const bf16_t* gp = P + row * PW + 3584 + cb0; const u32x4 g0 = *(const u32x4*)gp, g1 = *(const u32x4*)(gp + 8);
        u32x4 cur[4];
#pragma unroll
        for (int nt = 0; nt < 4; ++nt) cur[nt] = pk[nt];
        if (sub < 3) {
#pragma unroll
            for (int nt = 0; nt < 4; ++nt) pk[nt] = *(const u32x4*)(cache + ((size_t)(((sub + 1) * 4 + nt) * 512 + tid)) * 16); }
        LDS_WAIT();
#pragma unroll
        for (int nt = 0; nt < 4; ++nt) {
            const unsigned cw[4] = {cur[nt].x, cur[nt].y, cur[nt].z, cur[nt].w};
            float av[4], bv[4];
#pragma unroll
            for (int e = 0; e < 4; ++e) { av[e] = __expf(bf_lo(cw[e])); bv[e] = bf_hi(cw[e]); }
            const float Pq = (av[0] * av[1]) * (av[2] * av[3]);
            const float Hq = ((bv[0] * av[1] + bv[1]) * av[2] + bv[2]) * av[3] + bv[3];
            const float P0 = bperm((ql) << 2, Pq), P1 = bperm((ql + 16) << 2, Pq), P2 = bperm((ql + 32) << 2, Pq), P3 = bperm((ql + 48) << 2, Pq);
            const float H0 = bperm((ql) << 2, Hq), H1 = bperm((ql + 16) << 2, Hq), H2 = bperm((ql + 32) << 2, Hq), H3 = bperm((ql + 48) << 2, Hq);
            const float c0 = hst[nt], c1 = P0 * c0 + H0, c2 = P1 * c1 + H1, c3 = P2 * c2 + H2;
            float hh = quad == 0 ? c0 : (quad == 1 ? c1 : (quad == 2 ? c2 : c3));
#pragma unroll
            for (int e = 0; e < 4; ++e) { hh = av[e] * hh + bv[e]; XC[(quad * 4 + e) * 68 + nt * 16 + ql] = hh; }
            hst[nt] = P3 * c3 + H3;
        }
        LDS_WAIT();
        const f32x4 h0 = *(const LAS f32x4*)(XC + tk * 68 + cg4), h1 = *(const LAS f32x4*)(XC + tk * 68 + cg4 + 4), h2 = *(const LAS f32x4*)(XC + tk * 68 + cg4 + 8), h3 = *(const LAS f32x4*)(XC + tk * 68 + cg4 + 12);
        u32x4 o0, o1;
        o0.x = cvt_pk_bf16(h0[0] * siluf_(bf_lo(g0.x)), h0[1] * siluf_(bf_hi(g0.x))); o0.y = cvt_pk_bf16(h0[2] * siluf_(bf_lo(g0.y)), h0[3] * siluf_(bf_hi(g0.y)));
        o0.z = cvt_pk_bf16(h1[0] * siluf_(bf_lo(g0.z)), h1[1] * siluf_(bf_hi(g0.z))); o0.w = cvt_pk_bf16(h1[2] * siluf_(bf_lo(g0.w)), h1[3] * siluf_(bf_hi(g0.w)));
        o1.x = cvt_pk_bf16(h2[0] * siluf_(bf_lo(g1.x)), h2[1] * siluf_(bf_hi(g1.x))); o1.y = cvt_pk_bf16(h2[2] * siluf_(bf_lo(g1.y)), h2[3] * siluf_(bf_hi(g1.y)));
        o1.z = cvt_pk_bf16(h3[0] * siluf_(bf_lo(g1.z)), h3[1] * siluf_(bf_hi(g1.z))); o1.w = cvt_pk_bf16(h3[2] * siluf_(bf_lo(g1.w)), h3[3] * siluf_(bf_hi(g1.w)));
        bf16_t* yp = Y23 + row * 1024 + cb0; *(u32x4*)yp = o0; *(u32x4*)(yp + 8) = o1;
    }
}

typedef const __attribute__((address_space(4))) Args* ArgsP;
__device__ __forceinline__ ArgsP args_ptr() { ArgsP p = (ArgsP)__builtin_amdgcn_kernarg_segment_ptr(); asm volatile("" : "+s"(p)); return p; }
__global__ void __launch_bounds__(512, 2) mk_fwd(Args a_unused) {
    extern __shared__ __attribute__((aligned(16))) unsigned char lds_[];
    LAS unsigned char* lds = (LAS unsigned char*)lds_;
    cg::grid_group grid = cg::this_grid();
    volatile LAS unsigned* bst = (volatile LAS unsigned*)(lds + LDS_BARW);
    { ArgsP ap0 = args_ptr(); unsigned* bar0 = (unsigned*)(ap0->ws);
      if (tid_() == 0) { bst[0] = 0u; bst[1] = 0u; (void)xb_add(&bar0[XB_XCNT(xb_xcc_id())], 1u); } }
#define GRID_BAR() do { ArgsP apb = args_ptr(); xcd_barrier((unsigned*)(apb->ws), bst); } while (0)

    {
        __syncthreads();
        ArgsP ap = args_ptr(); unsigned char* ws = ap->ws;
        const int tid = tid_(), lane = tid & 63, wave = __builtin_amdgcn_readfirstlane(tid >> 6), c = bid_(), G = gridDim.x;
        bf16_t* Wpool_t = (bf16_t*)(ws + WS_SMALL); bf16_t* Wrg_t = (bf16_t*)(ws + WS_SMALL + 262144); bf16_t* Wig_t = (bf16_t*)(ws + WS_SMALL + 262144 + 131072);
        bf16_t* MEMB = (bf16_t*)(ws + WS_MEMB); bf16_t* Win_t = (bf16_t*)(ws + WS_WIN); bf16_t* Wb_t = (bf16_t*)(ws + WS_WB); bf16_t* Wo_t = (bf16_t*)(ws + WS_WO); bf16_t* Wkv_t = (bf16_t*)(ws + WS_WKV);
        bf16_t* XN = (bf16_t*)(ws + WS_XN);
        LAS float* scr = (LAS float*)(lds + wave * 16384);
        const int gw = c * 8 + wave, NGW = G * 8;
        constexpr int I_IN = 16 * 288, I_BR = 8 * 32, I_SQ = 16 * 32, I_PL = 2 * 4, I_RG = 1 * 2;
        constexpr int N_IN = 2 * I_IN, N_BR = 8 * I_BR, N_O = 2 * I_SQ, N_KV = 2 * I_SQ, N_PL = 8 * I_PL, N_RG = 16 * I_RG;
        constexpr int NITEMS = N_IN + N_BR + N_O + N_KV + N_PL + 2 * N_RG;
#define P0_DECODE(IT, T) do { int r_ = (IT); \
            if (r_ < N_IN) { const int l_ = r_ / I_IN; T = TItem{ap->w_in + (size_t)l_ * DM * NIN, Win_t + (size_t)l_ * NIN * DM, NIN, DM, r_ % I_IN}; break; } r_ -= N_IN; \
            if (r_ < N_BR) { const int q_ = r_ / I_BR; T = TItem{ap->w_branch + (size_t)q_ * 512 * DM, Wb_t + (size_t)q_ * 1024 * 1024, DM, 1024, r_ % I_BR}; break; } r_ -= N_BR; \
            if (r_ < N_O) { const int l_ = r_ / I_SQ; T = TItem{ap->w_out + (size_t)l_ * DM * DM, Wo_t + (size_t)l_ * DM * DM, DM, DM, r_ % I_SQ}; break; } r_ -= N_O; \
            if (r_ < N_KV) { const int l_ = r_ / I_SQ; T = TItem{ap->w_mem_kv + (size_t)l_ * DM * DM, Wkv_t + (size_t)l_ * DM * DM, DM, DM, r_ % I_SQ}; break; } r_ -= N_KV; \
            if (r_ < N_PL) { const int q_ = r_ / I_PL; T = TItem{ap->w_pool + (size_t)q_ * 128 * 128, Wpool_t + (size_t)q_ * 128 * 128, 128, 128, r_ % I_PL}; break; } r_ -= N_PL; \
            if (r_ < N_RG) { const int q_ = r_ / I_RG; T = TItem{ap->w_rg + (size_t)q_ * 64 * 64, Wrg_t + (size_t)q_ * 64 * 64, 64, 64, r_ % I_RG}; break; } r_ -= N_RG; \
            { const int q_ = r_ / I_RG; T = TItem{ap->w_ig + (size_t)q_ * 64 * 64, Wig_t + (size_t)q_ * 64 * 64, 64, 64, r_ % I_RG}; } } while (0)
        for (int it = gw; it < NITEMS; it += 2 * NGW) {
            const bool hb = (it + NGW < NITEMS);
            TItem ta_, tb_; P0_DECODE(it, ta_); P0_DECODE(hb ? it + NGW : it, tb_);
            f32x4 va[8], vb[8];
            tr_load(ta_, lane, va); if (hb) tr_load(tb_, lane, vb);
            tr_finish(ta_, lane, va, scr); if (hb) tr_finish(tb_, lane, vb, scr);
        }
        const float* x = ap->x; const float* mem = ap->mem;
        const size_t gt = (size_t)c * 512 + tid, GT = (size_t)G * 512;
        for (size_t i = gt; i < (size_t)NBATCH * SEQ * DM / 8; i += 4 * GT) {
            f32x4 v0[4], v1[4];
#pragma unroll
            for (int q = 0; q < 4; ++q) { v0[q] = __builtin_nontemporal_load((const f32x4*)(x + (i + q * GT) * 8)); v1[q] = __builtin_nontemporal_load((const f32x4*)(x + (i + q * GT) * 8 + 4)); }
#pragma unroll
            for (int q = 0; q < 4; ++q) { u32x4 o; o.x = cvt_pk_bf16(v0[q][0], v0[q][1]); o.y = cvt_pk_bf16(v0[q][2], v0[q][3]); o.z = cvt_pk_bf16(v1[q][0], v1[q][1]); o.w = cvt_pk_bf16(v1[q][2], v1[q][3]);
                *(u32x4*)(XN + (i + q * GT) * 8) = o; } }
        for (size_t i = gt; i < (size_t)NBATCH * MEMLEN * DM / 8; i += GT) { const f32x4 v0 = *(const f32x4*)(mem + i * 8), v1 = *(const f32x4*)(mem + i * 8 + 4);
            u32x4 o; o.x = pk2(v0[0], v0[1]); o.y = pk2(v0[2], v0[3]); o.z = pk2(v1[0], v1[1]); o.w = pk2(v1[2], v1[3]); *(u32x4*)(MEMB + i * 8) = o; }
    }
    if (gridDim.x == 0x7fffffffu) grid.sync();
    GRID_BAR();

    for (int l = 0; l < NLAYER; ++l) {
        for (int b = 0; b < NBATCH; ++b) {
            {
                __syncthreads();
                ArgsP ap = args_ptr(); unsigned char* ws = ap->ws; const int c = bid_();
                SchedP1 S{(const char*)(ws + WS_XN) + (size_t)b * SEQ * DM * 2, (const char*)(ws + WS_WIN) + (size_t)l * NIN * DM * 2, c};
                EpiP1 E{(bf16_t*)(ws + WS_PROJ), PW};
                pg8::gemm_phase<EpiP1, SchedP1, true>(lds, 2048, 2048, S, E);
            }
            if (l == 0 && b == 0) {
                ArgsP ap = args_ptr(); unsigned char* ws = ap->ws; const int c = bid_();
                __syncthreads();
                SchedKV S{(const char*)(ws + WS_MEMB), (const char*)(ws + WS_WKV), c};
                EpiP1 E{(bf16_t*)(ws + WS_KVM) + (size_t)(c >> 3) * 512 * 1024, 1024};
                pg8::gemm_phase<EpiP1, SchedKV, true>(lds, 2048, 2048, S, E);
            }
            GRID_BAR();
            {
                ArgsP ap = args_ptr(); unsigned char* ws = ap->ws; const int c = bid_();
                const bf16_t* PROJ = (const bf16_t*)(ws + WS_PROJ); bf16_t* Y23 = (bf16_t*)(ws + WS_Y) + (size_t)16384 * 1024;
                float* AGG = (float*)(ws + WS_AGG); float* GAGG = AGG + 256 * 1024;
                unsigned* bar = (unsigned*)ws; unsigned* cnt1 = bar + 3584 + 64 * (l * 2 + b); unsigned* cnt2 = bar + 3584 + 64 * (4 + l * 2 + b);
                __syncthreads();
                lru_stage(lds, ap->conv_w + (size_t)l * 2048, ap->conv_b + l * 512, ap->b_rg + l * 512, ap->b_ig + l * 512, ap->lru_L + l * 512);
                __syncthreads();
                lru_unit<false>(lds, PROJ, Y23, AGG, GAGG, (const bf16_t*)(ws + WS_SMALL + 262144) + (size_t)l * 32768, (const bf16_t*)(ws + WS_SMALL + 262144 + 131072) + (size_t)l * 32768, ws + WS_GSCR + ((size_t)c * 4 + 3) * 131072, c);
                flag_arrive_wt(cnt1);
                __syncthreads();
            }
            {
                __syncthreads();
                ArgsP ap = args_ptr(); unsigned char* ws = ap->ws; const int c = bid_(), G = gridDim.x;
                const bf16_t* PROJ = (const bf16_t*)(ws + WS_PROJ); bf16_t* Y01 = (bf16_t*)(ws + WS_Y);
                for (int u = c; u < 512; u += G) sb_unit(lds, PROJ, Y01, u & 3, tile_of(u));
                __syncthreads();
            }
            {
                ArgsP ap = args_ptr(); unsigned char* ws = ap->ws; const int c = bid_();
                float* AGG = (float*)(ws + WS_AGG); float* GAGG = AGG + 256 * 1024;
                unsigned* bar = (unsigned*)ws; unsigned* cnt1 = bar + 3584 + 64 * (l * 2 + b); unsigned* cnt2 = bar + 3584 + 64 * (4 + l * 2 + b);
                if (c < 16) {
                    flag_wait_nf(cnt1, 256u, bar);
                    const int ch = tid_(); float Pg = 1.f, Hg = 0.f; const float* ab = AGG + (size_t)c * 16 * 1024 + ch;
#pragma unroll
                    for (int i = 0; i < 16; ++i) { const float a = ld_agent(ab + i * 1024), bb = ld_agent(ab + i * 1024 + 512); Hg = a * Hg + bb; Pg *= a; }
                    __hip_atomic_store(GAGG + c * 1024 + ch, Pg, __ATOMIC_RELAXED, __HIP_MEMORY_SCOPE_AGENT); __hip_atomic_store(GAGG + c * 1024 + 512 + ch, Hg, __ATOMIC_RELAXED, __HIP_MEMORY_SCOPE_AGENT);
                    flag_arrive_wt(cnt2);
                }
            }
            {
                __syncthreads();
                ArgsP ap = args_ptr(); unsigned char* ws = ap->ws; const int c = bid_(), G = gridDim.x;
                const bf16_t* PROJ = (const bf16_t*)(ws + WS_PROJ); bf16_t* Y01 = (bf16_t*)(ws + WS_Y);
                const bf16_t* Wpool_t = (const bf16_t*)(ws + WS_SMALL); const float* psc = ap->pool_scale + l * 512;
                int gcur = -1;
                for (int u = c; u < 512; u += G) { const int g = u & 3;
                    if (g != gcur) { __syncthreads(); pool_stage(lds, Wpool_t + (size_t)(l * 4 + g) * 16384); __syncthreads(); gcur = g; }
                    pool_tile(lds, PROJ, Y01, psc, g, tile_of(u)); }
                __syncthreads();
            }
            {
                __syncthreads();
                ArgsP ap = args_ptr(); unsigned char* ws = ap->ws; const int c = bid_(), G = gridDim.x;
                const bf16_t* PROJ = (const bf16_t*)(ws + WS_PROJ); bf16_t* Y23 = (bf16_t*)(ws + WS_Y) + (size_t)16384 * 1024;
                const bf16_t* KVM = (const bf16_t*)(ws + WS_KVM) + (size_t)l * 512 * 1024 + (size_t)b * 256 * 1024;
                int hcur = -1;
                for (int u = c; u < 512; u += G) { const int h = u & 3;
                    if (h != hcur) { __syncthreads(); xa_stage(lds, KVM, h); __syncthreads(); hcur = h; }
                    xa_tile(lds, PROJ, Y23, h, u >> 2); }
            }
            {
                ArgsP ap = args_ptr(); unsigned char* ws = ap->ws; const int c = bid_();
                const bf16_t* PROJ = (const bf16_t*)(ws + WS_PROJ); bf16_t* Y23 = (bf16_t*)(ws + WS_Y) + (size_t)16384 * 1024;
                float* AGG = (float*)(ws + WS_AGG); float* GAGG = AGG + 256 * 1024;
                unsigned* bar = (unsigned*)ws; unsigned* cnt2 = bar + 3584 + 64 * (4 + l * 2 + b);
                __syncthreads();
                flag_wait_nf(cnt2, 16u, bar);
                lru_final(lds, PROJ, Y23, AGG, GAGG, ws + WS_GSCR + ((size_t)c * 4 + 3) * 131072, c);
            }
            {
                __syncthreads();
                ArgsP ap = args_ptr(); unsigned char* ws = ap->ws; const int c = bid_();
                SchedP3G S{(const char*)(ws + WS_XN) + (size_t)b * SEQ * DM * 2, (const char*)(ws + WS_WIN) + ((size_t)l * NIN + 5120) * DM * 2, c};
                EpiP3G E{ws + WS_GSCR + (size_t)c * 4 * 131072};
                pg8::gemm_phase<EpiP3G, SchedP3G, true>(lds, 2048, 2048, S, E);
            }
            GRID_BAR();
            {
                __syncthreads();
                ArgsP ap = args_ptr(); unsigned char* ws = ap->ws; const int c = bid_();
                SchedP3B S2{(const char*)(ws + WS_Y), (const char*)(ws + WS_WB) + (size_t)l * 4 * 1024 * 1024 * 2, c};
                EpiP3B E2{ws + WS_GSCR + (size_t)c * 4 * 131072, (bf16_t*)(ws + WS_GSCR + (size_t)c * 4 * 131072)};
                pg8::gemm_phase<EpiP3B, SchedP3B, true>(lds, 2048, 2048, S2, E2);
            }
            {
                ArgsP ap = args_ptr(); unsigned char* ws = ap->ws; const int c = bid_();
                const int pm = 8 * (c & 7) + ((c >> 3) >> 2);
                unsigned* bar = (unsigned*)ws; unsigned* cntA = bar + 4096 + (((l * 2 + b) * 2 + 0) * 64 + pm) * 16; unsigned* cntB = bar + 4096 + (((l * 2 + b) * 2 + 1) * 64 + pm) * 16;
                flag_arrive_wt(cntA);
                flag_wait(cntA, 4u, bar);
                const float* xres = (l == 0 ? ap->x : (const float*)ap->out) + (size_t)b * SEQ * DM;
                SchedP4 S{(const char*)(ws + WS_GSCR), (const char*)(ws + WS_WO) + (size_t)l * DM * DM * 2, c};
                EpiP4 E{xres, ap->out + (size_t)b * SEQ * DM, (l + 1 < NLAYER) ? (bf16_t*)(ws + WS_XN) + (size_t)b * SEQ * DM : (bf16_t*)nullptr, ap->ln_g + l * DM, ap->ln_b + l * DM,
                        (float*)(ws + WS_AGG + 1536 * 1024), cntB, bar};
                pg8::gemm_phase<EpiP4, SchedP4, true, true>(lds, 512, 2048, S, E);
            }
        }
    }
}

extern "C" void kernel_launch(void* const* d_in, const int* in_sizes, int n_in, void* d_out, int out_size, void* d_ws, size_t ws_size, hipStream_t stream) {
    static int ok = 0;
    if (ok == 0) {
        ok = 1;
        if (n_in != 17 || ws_size < WS_END) { fprintf(stderr, "kernel_launch: unexpected inputs (n_in %d, ws %zu)\n", n_in, ws_size); ok = -1; }
        if (hipFuncSetAttribute((const void*)mk_fwd, hipFuncAttributeMaxDynamicSharedMemorySize, LDS_BYTES) != hipSuccess) { fprintf(stderr, "kernel_launch: hipFuncSetAttribute failed\n"); ok = -1; }
        (void)hipGetLastError();
    }
    if (ok < 0) return;
    Args a{};
    a.x = (const float*)d_in[0]; a.mem = (const float*)d_in[1]; a.w_in = (const float*)d_in[2]; a.w_pool = (const float*)d_in[3]; a.pool_scale = (const float*)d_in[4];
    a.conv_w = (const float*)d_in[5]; a.conv_b = (const float*)d_in[6]; a.w_rg = (const float*)d_in[7]; a.b_rg = (const float*)d_in[8]; a.w_ig = (const float*)d_in[9];
    a.b_ig = (const float*)d_in[10]; a.lru_L = (const float*)d_in[11]; a.w_mem_kv = (const float*)d_in[12]; a.w_branch = (const float*)d_in[13]; a.w_out = (const float*)d_in[14];
    a.ln_g = (const float*)d_in[15]; a.ln_b = (const float*)d_in[16]; a.out = (float*)d_out; a.ws = (unsigned char*)d_ws;
    (void)hipMemsetAsync(d_ws, 0, 49152, stream);
    void* args[] = {&a};
    hipError_t e = hipLaunchCooperativeKernel((const void*)mk_fwd, dim3(256), dim3(512), args, LDS_BYTES, stream);
    if (e != hipSuccess) fprintf(stderr, "kernel_launch: cooperative launch failed: %s\n", hipGetErrorString(e));
}
```
